# Optimizing an MI355X kernel written in HIP

```python
import math
import jax, jax.numpy as jnp
from jax import lax
import numpy as np

D_MODEL = 1024
BATCH = 8
SEQ = 2048
DEPTH = 2

D_S5 = 256
S5_GROUP = 16
S5_GROUPS = D_S5 // S5_GROUP
S5_STATE = 64
D_RG = 256
RG_BLOCKS = 8
RG_BLOCK = D_RG // RG_BLOCKS
RG_CONV = 4
RG_C = 8.0
N_HEADS = 8
N_KV_HEADS = 2
HEAD_DIM = 64
D_ATTN = N_HEADS * HEAD_DIM
KV_DIM = N_KV_HEADS * HEAD_DIM
Q_PER_KV = N_HEADS // N_KV_HEADS
IDX_HEADS = 8
IDX_DIM = 64
TOPK_MAX = 256
Q_BLOCK = 128
D_MIX = D_S5 + D_RG + D_ATTN
ROPE_THETA = 10000.0
D_FF = -(-8 * D_MODEL // (3 * 256)) * 256
D_PLE = 256
ALPHA = (2.0 * DEPTH) ** 0.25
BETA = (8.0 * DEPTH) ** -0.25
LN_EPS = 1e-5
IN_SIZES = (D_S5, D_RG, D_RG, D_ATTN, KV_DIM, KV_DIM, IDX_HEADS * IDX_DIM, IDX_DIM, IDX_HEADS)
N_IN = sum(IN_SIZES)

kernel_name = "hybrid_s5_rglru_dsa_deepnorm"


def _split_points():
    pts, acc = [], 0
    for s in IN_SIZES[:-1]:
        acc += s
        pts.append(acc)
    return pts


def layer_norm(x, g, b):
    xf = x.astype(jnp.float32)
    mu = jnp.mean(xf, axis=-1, keepdims=True)
    var = jnp.mean(jnp.square(xf - mu), axis=-1, keepdims=True)
    return ((xf - mu) * lax.rsqrt(var + LN_EPS) * g + b).astype(x.dtype)


def rope_tables(positions, dim):
    inv = ROPE_THETA ** (-jnp.arange(0, dim, 2, dtype=jnp.float32) / dim)
    ang = positions.astype(jnp.float32)[..., None] * inv
    return jnp.cos(ang)[:, :, None, :], jnp.sin(ang)[:, :, None, :]


def rope(x, cos, sin):
    cos = cos.astype(x.dtype)
    sin = sin.astype(x.dtype)
    x1, x2 = jnp.split(x, 2, axis=-1)
    return jnp.concatenate([x1 * cos - x2 * sin, x2 * cos + x1 * sin], axis=-1)


def _complex_linear_combine(e1, e2):
    a1r, a1i, b1r, b1i = e1
    a2r, a2i, b2r, b2i = e2
    ar = a2r * a1r - a2i * a1i
    ai = a2r * a1i + a2i * a1r
    br = a2r * b1r - a2i * b1i + b2r
    bi = a2r * b1i + a2i * b1r + b2i
    return ar, ai, br, bi


def _real_linear_combine(e1, e2):
    a1, b1 = e1
    a2, b2 = e2
    return a2 * a1, a2 * b1 + b2


def s5_mixer(u, lam_re, lam_im, log_step, b_re, b_im, c_re, c_im, d_skip, w_glu, b_glu):
    bsz, L, _ = u.shape
    uf = u.astype(jnp.float32)
    ug = uf.reshape(bsz, L, S5_GROUPS, S5_GROUP)
    lr = lam_re.astype(jnp.float32)
    li = lam_im.astype(jnp.float32)
    step = jnp.exp(log_step.astype(jnp.float32))[:, None]
    mag = jnp.exp(lr * step)
    ar = mag * jnp.cos(li * step)
    ai = mag * jnp.sin(li * step)
    den = lr * lr + li * li
    nr, ni = ar - 1.0, ai
    cr = (nr * lr + ni * li) / den
    ci = (ni * lr - nr * li) / den
    br = b_re.astype(jnp.float32)
    bi = b_im.astype(jnp.float32)
    bbr = cr[..., None] * br - ci[..., None] * bi
    bbi = cr[..., None] * bi + ci[..., None] * br
    bu_r = jnp.einsum('blgc,gpc->blgp', ug, bbr)
    bu_i = jnp.einsum('blgc,gpc->blgp', ug, bbi)
    a_r = jnp.broadcast_to(ar, bu_r.shape)
    a_i = jnp.broadcast_to(ai, bu_r.shape)
    _, _, xr, xi = lax.associative_scan(_complex_linear_combine, (a_r, a_i, bu_r, bu_i), axis=1)
    y = (jnp.einsum('blgp,gcp->blgc', xr, c_re.astype(jnp.float32))
         - jnp.einsum('blgp,gcp->blgc', xi, c_im.astype(jnp.float32)))
    y = y.reshape(bsz, L, D_S5) + d_skip.astype(jnp.float32) * uf
    y = jax.nn.gelu(y)
    y = y * jax.nn.sigmoid(y @ w_glu.astype(jnp.float32) + b_glu.astype(jnp.float32))
    return y.astype(u.dtype)


def rglru_mixer(xr, gate, conv_w, conv_b, wa, ba, wx, bx, lam):
    bsz, L, _ = xr.shape
    xpad = jnp.pad(xr, ((0, 0), (RG_CONV - 1, 0), (0, 0)))
    xc = conv_b
    for k in range(RG_CONV):
        xc = xc + conv_w[k] * xpad[:, k:k + L]
    xb = xc.reshape(bsz, L, RG_BLOCKS, RG_BLOCK)
    r = jax.nn.sigmoid(jnp.einsum('blhi,hij->blhj', xb, wa).reshape(bsz, L, D_RG) + ba)
    ig = jax.nn.sigmoid(jnp.einsum('blhi,hij->blhj', xb, wx).reshape(bsz, L, D_RG) + bx)
    log_a = -RG_C * r.astype(jnp.float32) * jax.nn.softplus(-lam.astype(jnp.float32))
    a = jnp.exp(log_a)
    mult = jnp.sqrt(-jnp.expm1(2.0 * log_a))
    bvals = mult * (ig * xc).astype(jnp.float32)
    _, h = lax.associative_scan(_real_linear_combine, (a, bvals), axis=1)
    return h.astype(xr.dtype) * jax.nn.gelu(gate)


def dsa_mixer(q, k, v, qi, ki, wi, positions):
    bsz, L, _ = q.shape
    q = q.reshape(bsz, L, N_HEADS, HEAD_DIM)
    k = k.reshape(bsz, L, N_KV_HEADS, HEAD_DIM)
    v = v.reshape(bsz, L, N_KV_HEADS, HEAD_DIM)
    qi = qi.reshape(bsz, L, IDX_HEADS, IDX_DIM)
    cos, sin = rope_tables(positions, HEAD_DIM)
    q = rope(q, cos, sin)
    k = rope(k, cos, sin)
    qi = rope(qi, cos, sin)
    ki = rope(ki[:, :, None, :], cos, sin)[:, :, 0]
    top = min(TOPK_MAX, L // 4)
    nblk = L // Q_BLOCK
    q_b = q.reshape(bsz, nblk, Q_BLOCK, N_KV_HEADS, Q_PER_KV, HEAD_DIM).transpose(1, 0, 2, 3, 4, 5)
    qi_b = qi.reshape(bsz, nblk, Q_BLOCK, IDX_HEADS, IDX_DIM).transpose(1, 0, 2, 3, 4)
    wi_b = wi.reshape(bsz, nblk, Q_BLOCK, IDX_HEADS).transpose(1, 0, 2, 3)
    key_pos = jnp.arange(L)
    idx_scale = (IDX_HEADS * IDX_DIM) ** -0.5
    att_scale = HEAD_DIM ** -0.5

    def block(args):
        blk, qb, qib, wib = args
        t = blk * Q_BLOCK + jnp.arange(Q_BLOCK)
        causal = key_pos[None, :] <= t[:, None]
        rel = jax.nn.relu(jnp.einsum('bthd,bsd->bths', qib, ki).astype(jnp.float32))
        score = jnp.einsum('bths,bth->bts', rel, wib.astype(jnp.float32)) * idx_scale
        score = jnp.where(causal[None], score, -jnp.inf)
        _, idx = lax.top_k(score, top)
        valid = idx <= t[None, :, None]
        k_sel = jax.vmap(lambda kk, ii: kk[ii])(k, idx)
        v_sel = jax.vmap(lambda vv, ii: vv[ii])(v, idx)
        logits = jnp.einsum('btgrd,btkgd->btgrk', qb, k_sel).astype(jnp.float32) * att_scale
        logits = jnp.where(valid[:, :, None, None, :], logits, -jnp.inf)
        probs = jax.nn.softmax(logits, axis=-1).astype(v.dtype)
        o = jnp.einsum('btgrk,btkgd->btgrd', probs, v_sel)
        return o.reshape(bsz, Q_BLOCK, D_ATTN)

    out = lax.map(block, (jnp.arange(nblk), q_b, qi_b, wi_b))
    return out.transpose(1, 0, 2, 3).reshape(bsz, L, D_ATTN)


def setup_inputs(seed: int = 0) -> dict:
    key = jax.random.key(seed)
    ks = iter(jax.random.split(key, 48))
    f32 = jnp.float32

    def nrm(shape, scale):
        return scale * jax.random.normal(next(ks), shape, f32)

    x = nrm((BATCH, SEQ, D_MODEL), 1.0)
    p = nrm((DEPTH, BATCH, SEQ, D_PLE), 1.0)
    offs = jax.random.randint(next(ks), (BATCH, 1), 0, 4096, dtype=jnp.int32)
    positions = (offs + jnp.arange(SEQ, dtype=jnp.int32)[None, :]).astype(jnp.int32)
    ln_emb_g = 1.0 + nrm((D_MODEL,), 0.02)
    ln_emb_b = nrm((D_MODEL,), 0.02)
    w_in = nrm((DEPTH, D_MODEL, N_IN), D_MODEL ** -0.5)
    s5_lam_re = -0.5 + nrm((DEPTH, S5_GROUPS, S5_STATE), 0.01)
    s5_lam_im = math.pi * jnp.arange(S5_STATE, dtype=f32) + nrm((DEPTH, S5_GROUPS, S5_STATE), 0.01)
    s5_log_step = jax.random.uniform(next(ks), (DEPTH, S5_GROUPS), f32, math.log(1e-3), math.log(1e-1))
    s5_b_re = nrm((DEPTH, S5_GROUPS, S5_STATE, S5_GROUP), (2 * S5_GROUP) ** -0.5)
    s5_b_im = nrm((DEPTH, S5_GROUPS, S5_STATE, S5_GROUP), (2 * S5_GROUP) ** -0.5)
    s5_c_re = nrm((DEPTH, S5_GROUPS, S5_GROUP, S5_STATE), S5_STATE ** -0.5)
    s5_c_im = nrm((DEPTH, S5_GROUPS, S5_GROUP, S5_STATE), S5_STATE ** -0.5)
    s5_d = nrm((DEPTH, D_S5), 1.0)
    s5_w_glu = nrm((DEPTH, D_S5, D_S5), D_S5 ** -0.5)
    s5_b_glu = nrm((DEPTH, D_S5), 0.02)
    rg_conv_w = nrm((DEPTH, RG_CONV, D_RG), RG_CONV ** -0.5)
    rg_conv_b = nrm((DEPTH, D_RG), 0.02)
    rg_wa = nrm((DEPTH, RG_BLOCKS, RG_BLOCK, RG_BLOCK), RG_BLOCK ** -0.5)
    rg_ba = nrm((DEPTH, D_RG), 0.02)
    rg_wx = nrm((DEPTH, RG_BLOCKS, RG_BLOCK, RG_BLOCK), RG_BLOCK ** -0.5)
    rg_bx = nrm((DEPTH, D_RG), 0.02)
    a_c = jax.random.uniform(next(ks), (DEPTH, D_RG), f32, 0.9, 0.999)
    a0 = a_c ** (1.0 / RG_C)
    rg_lam = jnp.log(a0) - jnp.log1p(-a0)
    w_out = nrm((DEPTH, D_MIX, D_MODEL), BETA * D_MIX ** -0.5)
    ln1_g = 1.0 + nrm((DEPTH, D_MODEL), 0.02)
    ln1_b = nrm((DEPTH, D_MODEL), 0.02)
    ffn_w_up = nrm((DEPTH, D_MODEL, 2 * D_FF), D_MODEL ** -0.5)
    ffn_w_down = nrm((DEPTH, D_FF, D_MODEL), BETA * D_FF ** -0.5)
    ple_w_gate = nrm((DEPTH, D_MODEL, D_MODEL), D_MODEL ** -0.5)
    ple_w_proj = nrm((DEPTH, D_PLE, D_MODEL), BETA * D_PLE ** -0.5)
    ln2_g = 1.0 + nrm((DEPTH, D_MODEL), 0.02)
    ln2_b = nrm((DEPTH, D_MODEL), 0.02)
    return {
        "x": x, "p": p, "positions": positions,
        "ln_emb_g": ln_emb_g, "ln_emb_b": ln_emb_b, "w_in": w_in,
        "s5_lam_re": s5_lam_re, "s5_lam_im": s5_lam_im, "s5_log_step": s5_log_step,
        "s5_b_re": s5_b_re, "s5_b_im": s5_b_im, "s5_c_re": s5_c_re, "s5_c_im": s5_c_im,
        "s5_d": s5_d, "s5_w_glu": s5_w_glu, "s5_b_glu": s5_b_glu,
        "rg_conv_w": rg_conv_w, "rg_conv_b": rg_conv_b, "rg_wa": rg_wa, "rg_ba": rg_ba,
        "rg_wx": rg_wx, "rg_bx": rg_bx, "rg_lam": rg_lam,
        "w_out": w_out, "ln1_g": ln1_g, "ln1_b": ln1_b,
        "ffn_w_up": ffn_w_up, "ffn_w_down": ffn_w_down,
        "ple_w_gate": ple_w_gate, "ple_w_proj": ple_w_proj,
        "ln2_g": ln2_g, "ln2_b": ln2_b,
    }


def reference(x, p, positions, ln_emb_g, ln_emb_b, w_in,
              s5_lam_re, s5_lam_im, s5_log_step, s5_b_re, s5_b_im, s5_c_re, s5_c_im,
              s5_d, s5_w_glu, s5_b_glu,
              rg_conv_w, rg_conv_b, rg_wa, rg_ba, rg_wx, rg_bx, rg_lam,
              w_out, ln1_g, ln1_b, ffn_w_up, ffn_w_down, ple_w_gate, ple_w_proj,
              ln2_g, ln2_b):
    pts = _split_points()
    h = layer_norm(x, ln_emb_g, ln_emb_b)
    for i in range(DEPTH):
        proj = h @ w_in[i]
        u_s5, x_rg, g_rg, q, k, v, qi, ki, wi = jnp.split(proj, pts, axis=-1)
        y_s5 = s5_mixer(u_s5, s5_lam_re[i], s5_lam_im[i], s5_log_step[i], s5_b_re[i], s5_b_im[i],
                        s5_c_re[i], s5_c_im[i], s5_d[i], s5_w_glu[i], s5_b_glu[i])
        y_rg = rglru_mixer(x_rg, g_rg, rg_conv_w[i], rg_conv_b[i], rg_wa[i], rg_ba[i],
                           rg_wx[i], rg_bx[i], rg_lam[i])
        y_at = dsa_mixer(q, k, v, qi, ki, wi, positions)
        mix = jnp.concatenate([y_s5, y_rg, y_at], axis=-1) @ w_out[i]
        h = layer_norm(ALPHA * h + mix, ln1_g[i], ln1_b[i])
        gate_up = h @ ffn_w_up[i]
        g_ff, u_ff = jnp.split(gate_up, 2, axis=-1)
        ffn = (jax.nn.silu(g_ff) * u_ff) @ ffn_w_down[i]
        ple = jax.nn.sigmoid(h @ ple_w_gate[i]) * (p[i] @ ple_w_proj[i])
        h = layer_norm(ALPHA * h + ffn + ple, ln2_g[i], ln2_b[i])
    return h
```

```cpp
#include <hip/hip_runtime.h>
#include <hip/hip_cooperative_groups.h>
#include <cstdio>
#include <cstdint>
namespace cg = cooperative_groups;
namespace pg8 {
#define PG8_LAS __attribute__((address_space(3)))
typedef unsigned short bf16_t;
typedef short bf16x8 __attribute__((ext_vector_type(8)));
typedef float f32x4 __attribute__((ext_vector_type(4)));
typedef unsigned u32x4 __attribute__((ext_vector_type(4)));
constexpr int BM = 256, BK = 64, HALF = 128, HTB = HALF * BK * 2  , STAGE_BYTES = 8 * HTB, NXCD = 8, WGM = 8;

__host__ __device__ __forceinline__ int lds_byte(int r, int c) { const int st = (r >> 4) * 2 + (c >> 5), rr = r & 15, cc = c & 31, ob = rr * 64 + cc * 2; return st * 1024 + (ob ^ (((ob >> 9) & 1) << 5)); }
__host__ __device__ __forceinline__ void stage_rc(int b, int& R, int& C) { const int st = b / 1024, sb = b % 1024, swz = sb ^ (((sb >> 9) & 1) << 5); R = (st >> 1) * 16 + swz / 64; C = (st & 1) * 32 + (swz % 64) / 2; }
__host__ __device__ __forceinline__ int perm32(int rho) { const int n = rho >> 4, i = rho & 15; return 8 * (i >> 2) + 4 * n + (i & 3); }

struct Unit { int pm, pn; };
struct Gemm { const bf16_t* A; const bf16_t* Bt; int M, N, K; };

struct StaticOrder {
    int nM, nN, nwg, G, c;
    __host__ __device__ void init(int M, int N, int G_, int c_) { nM = M / BM; nN = N / BM; nwg = nM * nN; G = G_; c = c_; }
    __host__ __device__ bool next(int i, Unit& u) const {
        const long L = (long)i * G + c; if (L >= nwg) return false;
        int wgid = (int)L; { const int q = nwg / NXCD, r = nwg % NXCD, xcd = wgid % NXCD, off = wgid / NXCD; wgid = (xcd < r ? xcd * (q + 1) : r * (q + 1) + (xcd - r) * q) + off; }
        const int nig = WGM * nN, gid = wgid / nig, fm = gid * WGM, gsz = (nM - fm) < WGM ? (nM - fm) : WGM;
        u.pm = fm + ((wgid % nig) % gsz); u.pn = (wgid % nig) / gsz; return true;
    }
    __device__ __forceinline__ void a_ready(const Unit&) const {}
    __device__ __forceinline__ void done(const Unit&) const {}
};

template <class Epi, class Sched, bool ALIGN_EPI = false, bool SP2 = false>
__device__ __forceinline__ void gemm_phase(PG8_LAS unsigned char* lds, const Gemm g, const Sched& S, const Epi& E) {
    int tid = threadIdx.x; asm volatile("" : "+v"(tid));
    const int wid = __builtin_amdgcn_readfirstlane(tid >> 6), lane = tid & 63, wr = wid >> 2, wc = wid & 3, fr = lane & 15, fq = lane >> 4;
    const int K = g.K, nt = K / BK;
    unsigned voffA[2], voffB[2];
#pragma unroll
    for (int i = 0; i < 2; ++i) { int R, C; stage_rc(tid * 16 + i * 8192, R, C); const int Rb = Epi::PERM ? ((R & ~31) + perm32(R & 31)) : R;
        voffA[i] = (unsigned)(R * K + C) * 2u; voffB[i] = (unsigned)(Rb * K + C) * 2u; }
    const size_t kstep = (size_t)(BK * 2);
    const size_t hstep = (size_t)HALF * K * 2;
    const size_t tstep = 2 * hstep;
    const unsigned ldsw = (unsigned)wid * 1024u;
    const int aoff = lds_byte(wr * 64 + fr, fq * 8), boff = lds_byte(wc * 32 + fr, fq * 8);
#define PG8_SA(b, h) (((b) * 2 + (h)) * HTB)
#define PG8_SB(b, h) ((4 + (b) * 2 + (h)) * HTB)
#define PG8_STAGE(bufoff, gbase, voff) do { _Pragma("unroll") for (int _i = 0; _i < 2; ++_i) \
        __builtin_amdgcn_global_load_lds((const unsigned*)((const char*)(gbase) + (voff)[_i]), (PG8_LAS unsigned*)(lds + (bufoff) + ldsw + _i * 8192), 16, 0, 0); } while (0)
#define PG8_LDA(dst, b, h) do { _Pragma("unroll") for (int m = 0; m < 4; ++m) _Pragma("unroll") for (int k = 0; k < 2; ++k) dst[m][k] = *(const PG8_LAS bf16x8*)(lds + PG8_SA(b, h) + aoff + m * 2048 + k * 1024); } while (0)
#define PG8_LDB(dst, b, h) do { _Pragma("unroll") for (int n = 0; n < 2; ++n) _Pragma("unroll") for (int k = 0; k < 2; ++k) dst[n][k] = *(const PG8_LAS bf16x8*)(lds + PG8_SB(b, h) + boff + n * 2048 + k * 1024); } while (0)
#define PG8_MMA(ai, bj, At, Bt) do { __builtin_amdgcn_s_setprio(1); _Pragma("unroll") for (int m = 0; m < 4; ++m) _Pragma("unroll") for (int n = 0; n < 2; ++n) _Pragma("unroll") for (int k = 0; k < 2; ++k) \
        acc[ai][bj][m][n] = __builtin_amdgcn_mfma_f32_16x16x32_bf16(Bt[n][k], At[m][k], acc[ai][bj][m][n], 0, 0, 0); __builtin_amdgcn_s_setprio(0); } while (0)
#define PG8_WAIT_V(n) asm volatile("s_waitcnt vmcnt(" #n ")" ::: "memory")
#define PG8_WAIT_L(n) asm volatile("s_waitcnt lgkmcnt(" #n ")" ::: "memory")
#define PG8_BAR __builtin_amdgcn_s_barrier()
#define PG8_SCHED __builtin_amdgcn_sched_barrier(0)
    Unit cur, nxt; int ui = 0;
    if (!S.next(0, cur)) return;
    f32x4 acc[2][2][4][2];
#pragma unroll
    for (int a = 0; a < 2; ++a)
#pragma unroll
        for (int b = 0; b < 2; ++b)
#pragma unroll
            for (int m = 0; m < 4; ++m)
#pragma unroll
                for (int n = 0; n < 2; ++n) acc[a][b][m][n] = (f32x4){0.f, 0.f, 0.f, 0.f};
    bf16x8 At[4][2], B0[2][2], B1[2][2];
    const char* cA = (const char*)g.A + (size_t)cur.pm * tstep; const char* cB = (const char*)g.Bt + (size_t)cur.pn * tstep;
    S.a_ready(cur);
    if constexpr (SP2) {
        PG8_STAGE(PG8_SB(0, 0), cB, voffB); PG8_STAGE(PG8_SB(0, 1), cB + hstep, voffB); PG8_STAGE(PG8_SA(0, 0), cA, voffA); PG8_STAGE(PG8_SA(0, 1), cA + hstep, voffA);
        if (wr == 1) PG8_BAR;
        PG8_WAIT_V(2); PG8_BAR;
        PG8_STAGE(PG8_SB(1, 0), cB + kstep, voffB); PG8_STAGE(PG8_SA(1, 0), cA + kstep, voffA); PG8_STAGE(PG8_SB(1, 1), cB + hstep + kstep, voffB);
        PG8_WAIT_V(6); PG8_BAR;
    } else {
        PG8_STAGE(PG8_SB(0, 0), cB, voffB); PG8_STAGE(PG8_SA(0, 0), cA, voffA); PG8_STAGE(PG8_SB(0, 1), cB + hstep, voffB); PG8_STAGE(PG8_SA(0, 1), cA + hstep, voffA);
        if (wr == 1) PG8_BAR;
        PG8_WAIT_V(4); PG8_BAR;
        PG8_STAGE(PG8_SB(1, 0), cB + kstep, voffB); PG8_STAGE(PG8_SA(1, 0), cA + kstep, voffA); PG8_STAGE(PG8_SB(1, 1), cB + hstep + kstep, voffB);
        PG8_WAIT_V(6); PG8_BAR;
    }
    for (;;) {
        const bool has_next = S.next(ui + 1, nxt);
        const char* nA = has_next ? (const char*)g.A + (size_t)nxt.pm * tstep : cA; const char* nB = has_next ? (const char*)g.Bt + (size_t)nxt.pn * tstep : cB;
        for (int t = 0; t < nt; t += 2) {
            const bool last = (t == nt - 2);
            const char* a1 = cA + (size_t)(t + 1) * kstep;
            const char* a2 = last ? nA : cA + (size_t)(t + 2) * kstep; const char* b2 = last ? nB : cB + (size_t)(t + 2) * kstep;
            const char* a3 = a2 + kstep; const char* b3 = b2 + kstep;
            if (last && has_next) S.a_ready(nxt);
            if constexpr (SP2) {
            PG8_LDB(B0, 0, 0); PG8_LDB(B1, 0, 1); PG8_SCHED; PG8_LDA(At, 0, 0); PG8_STAGE(PG8_SA(1, 1), a1 + hstep, voffA);
            PG8_WAIT_V(8); PG8_WAIT_L(0); PG8_BAR; PG8_MMA(0, 0, At, B0); PG8_MMA(0, 1, At, B1); PG8_BAR; PG8_SCHED;
            PG8_LDA(At, 0, 1); PG8_STAGE(PG8_SB(0, 0), b2, voffB); PG8_STAGE(PG8_SB(0, 1), b2 + hstep, voffB); PG8_STAGE(PG8_SA(0, 0), a2, voffA);
            PG8_WAIT_V(8); PG8_WAIT_L(0); PG8_BAR; PG8_MMA(1, 0, At, B0); PG8_MMA(1, 1, At, B1); PG8_BAR; PG8_SCHED;
            PG8_LDB(B0, 1, 0); PG8_LDB(B1, 1, 1); PG8_SCHED; PG8_LDA(At, 1, 0); PG8_STAGE(PG8_SA(0, 1), a2 + hstep, voffA);
            PG8_WAIT_V(8); PG8_WAIT_L(0); PG8_BAR; PG8_MMA(0, 0, At, B0); PG8_MMA(0, 1, At, B1); PG8_BAR; PG8_SCHED;
            PG8_LDA(At, 1, 1); PG8_STAGE(PG8_SB(1, 0), b3, voffB); PG8_STAGE(PG8_SB(1, 1), b3 + hstep, voffB); PG8_STAGE(PG8_SA(1, 0), a3, voffA);
            PG8_WAIT_V(8); PG8_WAIT_L(0); PG8_BAR; PG8_MMA(1, 0, At, B0); PG8_MMA(1, 1, At, B1); PG8_BAR; PG8_SCHED;
            } else {
            PG8_LDB(B0, 0, 0); PG8_SCHED; PG8_LDA(At, 0, 0); PG8_STAGE(PG8_SA(1, 1), a1 + hstep, voffA);
            PG8_WAIT_L(8); PG8_BAR; PG8_WAIT_L(0); PG8_MMA(0, 0, At, B0); PG8_BAR; PG8_SCHED;
            PG8_LDB(B1, 0, 1); PG8_STAGE(PG8_SB(0, 0), b2, voffB);
            PG8_BAR; PG8_WAIT_L(0); PG8_MMA(0, 1, At, B1); PG8_BAR;
            PG8_LDA(At, 0, 1); PG8_STAGE(PG8_SA(0, 0), a2, voffA);
            PG8_BAR; PG8_WAIT_L(0); PG8_MMA(1, 0, At, B0); PG8_BAR; PG8_SCHED;
            PG8_STAGE(PG8_SB(0, 1), b2 + hstep, voffB);
            PG8_WAIT_V(6); PG8_BAR; PG8_MMA(1, 1, At, B1); PG8_BAR;
            PG8_LDB(B0, 1, 0); PG8_SCHED; PG8_LDA(At, 1, 0); PG8_STAGE(PG8_SA(0, 1), a2 + hstep, voffA);
            PG8_WAIT_L(8); PG8_BAR; PG8_WAIT_L(0); PG8_MMA(0, 0, At, B0); PG8_BAR; PG8_SCHED;
            PG8_LDB(B1, 1, 1); PG8_STAGE(PG8_SB(1, 0), b3, voffB);
            PG8_BAR; PG8_WAIT_L(0); PG8_MMA(0, 1, At, B1); PG8_BAR;
            PG8_LDA(At, 1, 1); PG8_STAGE(PG8_SA(1, 0), a3, voffA);
            PG8_BAR; PG8_WAIT_L(0); PG8_MMA(1, 0, At, B0); PG8_BAR; PG8_SCHED;
            PG8_STAGE(PG8_SB(1, 1), b3 + hstep, voffB);
            PG8_WAIT_V(6); PG8_BAR; PG8_MMA(1, 1, At, B1); PG8_BAR;
            }
        }
        if constexpr (ALIGN_EPI) { if (wr == 0) PG8_BAR; }
        if constexpr (!Epi::AFTER_DRAIN) { E(acc, cur, wr, wc, fr, fq); S.done(cur); }
        if (!has_next) break;
#pragma unroll
        for (int a = 0; a < 2; ++a)
#pragma unroll
            for (int b = 0; b < 2; ++b)
#pragma unroll
                for (int m = 0; m < 4; ++m)
#pragma unroll
                    for (int n = 0; n < 2; ++n) acc[a][b][m][n] = (f32x4){0.f, 0.f, 0.f, 0.f};
        cur = nxt; cA = nA; cB = nB; ++ui;
        if constexpr (ALIGN_EPI) { if (wr == 1) PG8_BAR; }
    }
    PG8_WAIT_V(0);
    if constexpr (!ALIGN_EPI) { if (wr == 0) PG8_BAR; }
    PG8_BAR;
    if constexpr (Epi::AFTER_DRAIN) { E.fused(acc, cur, wr, wc, fr, fq, lds, wid, lane); S.done(cur); }
#undef PG8_SA
#undef PG8_SB
#undef PG8_STAGE
#undef PG8_LDA
#undef PG8_LDB
#undef PG8_MMA
#undef PG8_WAIT_V
#undef PG8_WAIT_L
#undef PG8_BAR
#undef PG8_SCHED
}
}

#define LAS __attribute__((address_space(3)))
typedef unsigned short bf16_t;
typedef short bf16x8 __attribute__((ext_vector_type(8)));
typedef float f32x4 __attribute__((ext_vector_type(4)));
typedef float f32x16 __attribute__((ext_vector_type(16)));
typedef unsigned u32x2 __attribute__((ext_vector_type(2)));
typedef unsigned u32x4 __attribute__((ext_vector_type(4)));
typedef float f32x2_t __attribute__((ext_vector_type(2)));
typedef __bf16 bf16x2_t __attribute__((ext_vector_type(2)));

constexpr int BATCH = 8, SEQ = 2048, M = BATCH * SEQ, D = 1024, DEPTH = 2;
constexpr int N_IN = 2120, N_INP = 2304, DFF = 2816, NUP = 2 * DFF;
constexpr float ALPHA = 1.4142135623730951f;
constexpr float LN_EPS = 1e-5f;
constexpr float QSCALE = 0.125f * 1.4426950408889634f;
constexpr float IDX_SCALE = 0.04419417382415922f;
constexpr int NTHREADS = 512, NWAVES = 8;
constexpr int LDS_BYTES = 147456;

constexpr size_t MiB = 1u << 20;
constexpr size_t WS_W = 2 * MiB, W_LAYER = 26 * MiB;
constexpr size_t OW_IN = 0, OW_OUT = OW_IN + (size_t)N_INP * D * 2, OW_UP = OW_OUT + (size_t)D * D * 2, OW_DOWN = OW_UP + (size_t)NUP * D * 2,
                 OW_GATE = OW_DOWN + (size_t)D * DFF * 2, OW_PPROJ = OW_GATE + (size_t)D * D * 2, OW_GLU = OW_PPROJ + (size_t)D * 256 * 2, OW_END = OW_GLU + 256 * 256 * 2;
static_assert(OW_END <= W_LAYER, "weights per layer");
constexpr size_t WS_TAB = 54 * MiB, TAB_LAYER = 1 * MiB;
constexpr size_t TAB_LAM = 0, TAB_BBR = 65536, TAB_BBI = 131072, TAB_CM = 196608, TAB_SP = 262144;
constexpr size_t WS_ROPE = 56 * MiB, WS_HN = 60 * MiB, WS_PB = 92 * MiB, WS_SEL = 108 * MiB, WS_S5S = 112 * MiB, WS_Y = 114 * MiB;
constexpr size_t WS_U = 146 * MiB, WS_GRG = 154 * MiB, WS_XRG = 162 * MiB, WS_Q = 178 * MiB, WS_QI = 194 * MiB, WS_KB = 210 * MiB, WS_VT = 214 * MiB,
                 WS_KI = 218 * MiB, WS_WI = 220 * MiB, WS_RA = 222 * MiB, WS_RB = 238 * MiB, WS_ACT = 146 * MiB, WS_END = 256 * MiB;
static_assert(WS_ACT + (size_t)M * DFF * 2 <= WS_END, "act overlay");

__device__ __forceinline__ unsigned pkbf(float lo, float hi) { f32x2_t v = {lo, hi}; bf16x2_t b = __builtin_convertvector(v, bf16x2_t); return __builtin_bit_cast(unsigned, b); }
__device__ __forceinline__ float bf2f(unsigned short x) { return __uint_as_float((unsigned)x << 16); }
__device__ __forceinline__ float bflo(unsigned w) { return __uint_as_float(w << 16); }
__device__ __forceinline__ float bfhi(unsigned w) { return __uint_as_float(w & 0xffff0000u); }
__device__ __forceinline__ float sigmoidf_(float x) { return 1.0f / (1.0f + __expf(-x)); }
__device__ __forceinline__ float gelu_tanh(float x) { const float u = 0.7978845608028654f * (x + 0.044715f * x * x * x); return 0.5f * x * (1.0f + tanhf(u)); }
template <int CTRL> __device__ __forceinline__ float dppf(float v) { return __builtin_bit_cast(float, __builtin_amdgcn_update_dpp(0, __builtin_bit_cast(int, v), CTRL, 0xf, 0xf, true)); }
template <int CTRL> __device__ __forceinline__ int dppi(int v) { return __builtin_amdgcn_update_dpp(0, v, CTRL, 0xf, 0xf, true); }
__device__ __forceinline__ float rdl(float v, int l) { return __builtin_bit_cast(float, __builtin_amdgcn_readlane(__builtin_bit_cast(int, v), l)); }
__device__ __forceinline__ float wave_sum(float v) {
    v += dppf<0xB1>(v); v += dppf<0x4E>(v); v += dppf<0x141>(v); v += dppf<0x140>(v);
    return (rdl(v, 0) + rdl(v, 16)) + (rdl(v, 32) + rdl(v, 48));
}
__device__ __forceinline__ float wave_max(float v) {
    v = fmaxf(v, dppf<0xB1>(v)); v = fmaxf(v, dppf<0x4E>(v)); v = fmaxf(v, dppf<0x141>(v)); v = fmaxf(v, dppf<0x140>(v));
    return fmaxf(fmaxf(rdl(v, 0), rdl(v, 16)), fmaxf(rdl(v, 32), rdl(v, 48)));
}
__device__ __forceinline__ float wave_min(float v) {
    v = fminf(v, dppf<0xB1>(v)); v = fminf(v, dppf<0x4E>(v)); v = fminf(v, dppf<0x141>(v)); v = fminf(v, dppf<0x140>(v));
    return fminf(fminf(rdl(v, 0), rdl(v, 16)), fminf(rdl(v, 32), rdl(v, 48)));
}
__device__ __forceinline__ int wave_sum_i(int v) {
    v += dppi<0xB1>(v); v += dppi<0x4E>(v); v += dppi<0x141>(v); v += dppi<0x140>(v);
    return (__builtin_amdgcn_readlane(v, 0) + __builtin_amdgcn_readlane(v, 16)) + (__builtin_amdgcn_readlane(v, 32) + __builtin_amdgcn_readlane(v, 48));
}
__device__ __forceinline__ float xhalf_max(float v) { auto rr = __builtin_amdgcn_permlane32_swap(__float_as_uint(v), __float_as_uint(v), false, false); return fmaxf(__uint_as_float(rr[0]), __uint_as_float(rr[1])); }
__device__ __forceinline__ float xhalf_sum(float v) { auto rr = __builtin_amdgcn_permlane32_swap(__float_as_uint(v), __float_as_uint(v), false, false); return __uint_as_float(rr[0]) + __uint_as_float(rr[1]); }

using pg8::Unit;
struct EpiProj {
    static constexpr bool PERM = false, AFTER_DRAIN = false;
    bf16_t *U, *GRG, *Q, *KB, *VT, *QI, *KI; float *XRG, *WI; const float* ROPE;
    __device__ __forceinline__ void rope_half(const f32x4 (&acc)[2][2][4][2], int bj, const Unit& u, int wr, int wc, int fr, int fq, bf16_t* base, int ld, float sc) const {
        const int d0 = 16 * (wc & 1) + 4 * fq, hdl = wc >> 1;
#pragma unroll
        for (int ai = 0; ai < 2; ++ai)
#pragma unroll
            for (int m = 0; m < 4; ++m) {
                const int row = u.pm * 256 + ai * 128 + wr * 64 + m * 16 + fr;
                const f32x4 cs = *(const f32x4*)(ROPE + (size_t)row * 64 + d0) * sc, sn = *(const f32x4*)(ROPE + (size_t)row * 64 + 32 + d0) * sc;
                const f32x4 a0 = acc[ai][bj][m][0], a1 = acc[ai][bj][m][1];
                const f32x4 o1 = a0 * cs - a1 * sn, o2 = a1 * cs + a0 * sn;
                bf16_t* dst = base + (size_t)row * ld + 64 * hdl + d0;
                *(u32x2*)dst = (u32x2){pkbf(o1[0], o1[1]), pkbf(o1[2], o1[3])};
                *(u32x2*)(dst + 32) = (u32x2){pkbf(o2[0], o2[1]), pkbf(o2[2], o2[3])};
                asm volatile("" ::: "memory");
            }
    }
    __device__ __forceinline__ void operator()(const f32x4 (&acc)[2][2][4][2], const Unit& u, int wr, int wc, int fr, int fq) const {
        asm volatile("" : "+v"(fr), "+v"(fq));
        const int pn = u.pn;
        if (pn == 0 || pn == 2) {
            bf16_t* O = (pn == 0 ? U : GRG);
#pragma unroll
            for (int ai = 0; ai < 2; ++ai)
#pragma unroll
                for (int m = 0; m < 4; ++m) { bf16_t* rp = O + (size_t)(u.pm * 256 + ai * 128 + wr * 64 + m * 16 + fr) * 256 + wc * 32 + 4 * fq;
#pragma unroll
                    for (int bj = 0; bj < 2; ++bj)
#pragma unroll
                        for (int n = 0; n < 2; ++n) { const f32x4 v = acc[ai][bj][m][n]; *(u32x2*)(rp + bj * 128 + n * 16) = (u32x2){pkbf(v[0], v[1]), pkbf(v[2], v[3])}; }
                    asm volatile("" ::: "memory"); }
        } else if (pn == 1) {
#pragma unroll
            for (int ai = 0; ai < 2; ++ai)
#pragma unroll
                for (int m = 0; m < 4; ++m) { float* rp = XRG + (size_t)(u.pm * 256 + ai * 128 + wr * 64 + m * 16 + fr) * 256 + wc * 32 + 4 * fq;
#pragma unroll
                    for (int bj = 0; bj < 2; ++bj)
#pragma unroll
                        for (int n = 0; n < 2; ++n) *(f32x4*)(rp + bj * 128 + n * 16) = acc[ai][bj][m][n];
                    asm volatile("" ::: "memory"); }
        } else if (pn == 3 || pn == 4) {
            rope_half(acc, 0, u, wr, wc, fr, fq, Q + 256 * (pn - 3), 512, QSCALE); rope_half(acc, 1, u, wr, wc, fr, fq, Q + 256 * (pn - 3) + 128, 512, QSCALE);
        } else if (pn == 6 || pn == 7) {
            rope_half(acc, 0, u, wr, wc, fr, fq, QI + 256 * (pn - 6), 512, 1.0f); rope_half(acc, 1, u, wr, wc, fr, fq, QI + 256 * (pn - 6) + 128, 512, 1.0f);
        } else if (pn == 5) {
            rope_half(acc, 0, u, wr, wc, fr, fq, KB, 128, 1.0f);
            const int g = wc >> 1;
#pragma unroll
            for (int ai = 0; ai < 2; ++ai)
#pragma unroll
                for (int m = 0; m < 4; ++m) { const int row = u.pm * 256 + ai * 128 + wr * 64 + m * 16 + fr, b = row >> 11, t = row & 2047;
#pragma unroll
                    for (int n = 0; n < 2; ++n) { const f32x4 v = acc[ai][1][m][n];
#pragma unroll
                        for (int i = 0; i < 4; ++i) { const int d = 32 * (wc & 1) + 16 * n + 4 * fq + i; VT[((size_t)(b * 2 + g) * 64 + d) * 2048 + t] = (bf16_t)(pkbf(v[i], 0.f) & 0xffffu); } }
                    asm volatile("" ::: "memory"); }
        } else {
            if (wc < 2) rope_half(acc, 0, u, wr, wc, fr, fq, KI, 64, 1.0f);
            if (wc == 0 && fq < 2) {
#pragma unroll
                for (int ai = 0; ai < 2; ++ai)
#pragma unroll
                    for (int m = 0; m < 4; ++m) *(f32x4*)(WI + (size_t)(u.pm * 256 + ai * 128 + wr * 64 + m * 16 + fr) * 8 + 4 * fq) = acc[ai][1][m][0];
            }
        }
    }
};
struct EpiResid {
    static constexpr bool PERM = false, AFTER_DRAIN = false;
    float* H;
    __device__ __forceinline__ void operator()(const f32x4 (&acc)[2][2][4][2], const Unit& u, int wr, int wc, int fr, int fq) const {
        asm volatile("" : "+v"(fr), "+v"(fq));
#pragma unroll
        for (int ai = 0; ai < 2; ++ai)
#pragma unroll
            for (int m = 0; m < 4; ++m) { float* rp = H + (size_t)(u.pm * 256 + ai * 128 + wr * 64 + m * 16 + fr) * D + u.pn * 256 + wc * 32 + 4 * fq;
#pragma unroll
                for (int bj = 0; bj < 2; ++bj)
#pragma unroll
                    for (int n = 0; n < 2; ++n) { f32x4* p = (f32x4*)(rp + bj * 128 + n * 16); *p = *p * ALPHA + acc[ai][bj][m][n]; }
                asm volatile("" ::: "memory"); }
    }
};
struct EpiStoreBf16 {
    static constexpr bool PERM = false, AFTER_DRAIN = false;
    bf16_t* O; int ldc;
    __device__ __forceinline__ void operator()(const f32x4 (&acc)[2][2][4][2], const Unit& u, int wr, int wc, int fr, int fq) const {
        asm volatile("" : "+v"(fr), "+v"(fq));
#pragma unroll
        for (int ai = 0; ai < 2; ++ai)
#pragma unroll
            for (int m = 0; m < 4; ++m) { bf16_t* rp = O + (size_t)(u.pm * 256 + ai * 128 + wr * 64 + m * 16 + fr) * ldc + u.pn * 256 + wc * 32 + 4 * fq;
#pragma unroll
                for (int bj = 0; bj < 2; ++bj)
#pragma unroll
                    for (int n = 0; n < 2; ++n) { const f32x4 v = acc[ai][bj][m][n]; *(u32x2*)(rp + bj * 128 + n * 16) = (u32x2){pkbf(v[0], v[1]), pkbf(v[2], v[3])}; } }
    }
};
struct EpiSwiglu {
    static constexpr bool PERM = false, AFTER_DRAIN = false;
    bf16_t* ACT;
    __device__ __forceinline__ void operator()(const f32x4 (&acc)[2][2][4][2], const Unit& u, int wr, int wc, int fr, int fq) const {
        asm volatile("" : "+v"(fr), "+v"(fq));
#pragma unroll
        for (int ai = 0; ai < 2; ++ai)
#pragma unroll
            for (int m = 0; m < 4; ++m) { bf16_t* rp = ACT + (size_t)(u.pm * 256 + ai * 128 + wr * 64 + m * 16 + fr) * DFF + u.pn * 128 + wc * 32 + 4 * fq;
#pragma unroll
                for (int n = 0; n < 2; ++n) { const f32x4 g = acc[ai][0][m][n], uu = acc[ai][1][m][n]; f32x4 o;
#pragma unroll
                    for (int i = 0; i < 4; ++i) o[i] = g[i] * sigmoidf_(g[i]) * uu[i];
                    *(u32x2*)(rp + n * 16) = (u32x2){pkbf(o[0], o[1]), pkbf(o[2], o[3])}; } }
    }
};
struct EpiPle {
    static constexpr bool PERM = false, AFTER_DRAIN = false;
    bf16_t* PP;
    __device__ __forceinline__ void operator()(const f32x4 (&acc)[2][2][4][2], const Unit& u, int wr, int wc, int fr, int fq) const {
        asm volatile("" : "+v"(fr), "+v"(fq));
#pragma unroll
        for (int ai = 0; ai < 2; ++ai)
#pragma unroll
            for (int m = 0; m < 4; ++m) { bf16_t* rp = PP + (size_t)(u.pm * 256 + ai * 128 + wr * 64 + m * 16 + fr) * D + u.pn * 256 + wc * 32 + 4 * fq;
#pragma unroll
                for (int bj = 0; bj < 2; ++bj)
#pragma unroll
                    for (int n = 0; n < 2; ++n) { const f32x4 v = acc[ai][bj][m][n]; u32x2* p = (u32x2*)(rp + bj * 128 + n * 16); const u32x2 w = *p;
                        *p = (u32x2){pkbf(sigmoidf_(v[0]) * bflo(w[0]), sigmoidf_(v[1]) * bfhi(w[0])), pkbf(sigmoidf_(v[2]) * bflo(w[1]), sigmoidf_(v[3]) * bfhi(w[1]))}; }
                asm volatile("" ::: "memory"); }
    }
};
struct EpiDown {
    static constexpr bool PERM = false, AFTER_DRAIN = false;
    float* H; const bf16_t* PP;
    __device__ __forceinline__ void operator()(const f32x4 (&acc)[2][2][4][2], const Unit& u, int wr, int wc, int fr, int fq) const {
        asm volatile("" : "+v"(fr), "+v"(fq));
#pragma unroll
        for (int ai = 0; ai < 2; ++ai)
#pragma unroll
            for (int m = 0; m < 4; ++m) { const size_t off = (size_t)(u.pm * 256 + ai * 128 + wr * 64 + m * 16 + fr) * D + u.pn * 256 + wc * 32 + 4 * fq;
#pragma unroll
                for (int bj = 0; bj < 2; ++bj)
#pragma unroll
                    for (int n = 0; n < 2; ++n) { f32x4* p = (f32x4*)(H + off + bj * 128 + n * 16); const u32x2 w = *(const u32x2*)(PP + off + bj * 128 + n * 16);
                        const f32x4 pl = {bflo(w[0]), bfhi(w[0]), bflo(w[1]), bfhi(w[1])}; *p = *p * ALPHA + acc[ai][bj][m][n] + pl; }
                asm volatile("" ::: "memory"); }
    }
};

struct Args { const void* in[32]; float* out; unsigned char* ws; int ph_lo, ph_hi; };
typedef const __attribute__((address_space(4))) Args* KArgs;
struct Ctx {
    KArgs a; unsigned char* ws; LAS unsigned char* lds; unsigned char* ldsg;
    int tid, lane, wave, bid, G;
};
#define INF_(i, T) ((const T*)c.a->in[i])

__device__ __forceinline__ int colmap(int kind, int pos) {
    if (kind == 0) return pos;
    const int tile = pos >> 8, p = pos & 255, bj = p >> 7, ph = p & 127;
    if (kind == 2) return (bj ? DFF : 0) + 128 * tile + ph;
    const int wc = ph >> 5, n = (ph >> 4) & 1, fq = (ph >> 2) & 3, i = ph & 3;
    const int rc = 64 * (wc >> 1) + 32 * n + 16 * (wc & 1) + 4 * fq + i;
    if (tile <= 2) return pos;
    if (tile <= 4) return 768 + 256 * (tile - 3) + 128 * bj + rc;
    if (tile == 5) return bj == 0 ? 1280 + rc : 1408 + ph;
    if (tile <= 7) return 1536 + 256 * (tile - 6) + 128 * bj + rc;
    return bj == 0 ? (rc < 64 ? 2048 + rc : -1) : (ph < 8 ? 2112 + ph : -1);
}
__device__ __forceinline__ void transpose_item(const float* W, int K, int N, bf16_t* WT, int kind, LAS float* scr, int item, int nblk, int lane) {
    const int kb = item / nblk, nb = item % nblk, k0 = 64 * kb, n0 = 32 * nb;
    const int col = colmap(kind, n0 + (lane & 31));
#pragma unroll 8
    for (int i = 0; i < 32; ++i) { const int kk = 2 * i + (lane >> 5); scr[kk * 33 + (lane & 31)] = col >= 0 ? W[(size_t)(k0 + kk) * N + col] : 0.f; }
    asm volatile("s_waitcnt lgkmcnt(0)" ::: "memory");
    const int cc = lane & 7;
#pragma unroll
    for (int j = 0; j < 4; ++j) { const int n = (lane >> 3) + 8 * j; const LAS float* s = scr + (8 * cc) * 33 + n;
        u32x4 o; o.x = pkbf(s[0 * 33], s[1 * 33]); o.y = pkbf(s[2 * 33], s[3 * 33]); o.z = pkbf(s[4 * 33], s[5 * 33]); o.w = pkbf(s[6 * 33], s[7 * 33]);
        *(u32x4*)(WT + (size_t)(n0 + n) * K + k0 + 8 * cc) = o; }
    asm volatile("s_waitcnt lgkmcnt(0)" ::: "memory");
}
__device__ __forceinline__ void ln_row(const float* xrow, const float* g, const float* b, float* orow, bf16_t* brow, int lane) {
    const f32x4* xr = (const f32x4*)xrow + lane;
    f32x4 v[4]; float s = 0.f;
#pragma unroll
    for (int j = 0; j < 4; ++j) { v[j] = xr[64 * j]; s += (v[j][0] + v[j][1]) + (v[j][2] + v[j][3]); }
    const float mean = wave_sum(s) * (1.f / D); float s2 = 0.f;
#pragma unroll
    for (int j = 0; j < 4; ++j) { v[j] = v[j] - mean; s2 += (v[j][0] * v[j][0] + v[j][1] * v[j][1]) + (v[j][2] * v[j][2] + v[j][3] * v[j][3]); }
    const float rstd = 1.f / sqrtf(wave_sum(s2) * (1.f / D) + LN_EPS);
#pragma unroll
    for (int j = 0; j < 4; ++j) { const f32x4 gg = ((const f32x4*)g)[lane + 64 * j], bb = ((const f32x4*)b)[lane + 64 * j]; const f32x4 o = v[j] * rstd * gg + bb;
        ((f32x4*)orow)[lane + 64 * j] = o; ((u32x2*)brow)[lane + 64 * j] = (u32x2){pkbf(o[0], o[1]), pkbf(o[2], o[3])}; }
}
__device__ __forceinline__ void ln_pass(const Ctx& c, float* H, const float* g, const float* b, bf16_t* HN) {
    const int gw = c.bid * NWAVES + c.wave, NGW = c.G * NWAVES;
    for (int m = gw; m < M; m += NGW) ln_row(H + (size_t)m * D, g, b, H + (size_t)m * D, HN + (size_t)m * D, c.lane);
}

__device__ __forceinline__ void prologue(const Ctx& c) {
    const int gw = c.bid * NWAVES + c.wave, NGW = c.G * NWAVES;
    const int gt = c.bid * NTHREADS + c.tid, NGT = c.G * NTHREADS;
    {
        LAS float* scr = (LAS float*)(c.lds + c.wave * 16384);
        constexpr int I_IN = 16 * (N_INP / 32), I_OUT = 16 * 32, I_UP = 16 * (NUP / 32), I_DOWN = (DFF / 64) * 32, I_GATE = 16 * 32, I_PP = 4 * 32, I_GLU = 4 * 8;
        constexpr int I_LAYER = I_IN + I_OUT + I_UP + I_DOWN + I_GATE + I_PP + I_GLU;
        for (int it = gw; it < DEPTH * I_LAYER; it += NGW) {
            const int L = it / I_LAYER; int r = it % I_LAYER; unsigned char* wl = c.ws + WS_W + (size_t)L * W_LAYER;
            if (r < I_IN) { transpose_item(INF_(5, float) + (size_t)L * D * N_IN, D, N_IN, (bf16_t*)(wl + OW_IN), 1, scr, r, N_INP / 32, c.lane); continue; } r -= I_IN;
            if (r < I_OUT) { transpose_item(INF_(23, float) + (size_t)L * D * D, D, D, (bf16_t*)(wl + OW_OUT), 0, scr, r, 32, c.lane); continue; } r -= I_OUT;
            if (r < I_UP) { transpose_item(INF_(26, float) + (size_t)L * D * NUP, D, NUP, (bf16_t*)(wl + OW_UP), 2, scr, r, NUP / 32, c.lane); continue; } r -= I_UP;
            if (r < I_DOWN) { transpose_item(INF_(27, float) + (size_t)L * DFF * D, DFF, D, (bf16_t*)(wl + OW_DOWN), 0, scr, r, 32, c.lane); continue; } r -= I_DOWN;
            if (r < I_GATE) { transpose_item(INF_(28, float) + (size_t)L * D * D, D, D, (bf16_t*)(wl + OW_GATE), 0, scr, r, 32, c.lane); continue; } r -= I_GATE;
            if (r < I_PP) { transpose_item(INF_(29, float) + (size_t)L * 256 * D, 256, D, (bf16_t*)(wl + OW_PPROJ), 0, scr, r, 32, c.lane); continue; } r -= I_PP;
            transpose_item(INF_(14, float) + (size_t)L * 256 * 256, 256, 256, (bf16_t*)(wl + OW_GLU), 0, scr, r, 8, c.lane);
        }
    }
    {
        float* ROPE = (float*)(c.ws + WS_ROPE); const int* pos = INF_(2, int);
        for (int e = gt; e < M * 32; e += NGT) { const int m = e >> 5, i = e & 31;
            const float inv = (float)pow(10000.0, -(double)i / 32.0); const float ang = (float)pos[m] * inv;
            ROPE[(size_t)m * 64 + i] = (float)cos((double)ang); ROPE[(size_t)m * 64 + 32 + i] = (float)sin((double)ang); }
    }
    {
        const float* x = INF_(0, float); float* H = c.a->out; bf16_t* HN = (bf16_t*)(c.ws + WS_HN);
        for (int m = gw; m < M; m += NGW) ln_row(x + (size_t)m * D, INF_(3, float), INF_(4, float), H + (size_t)m * D, HN + (size_t)m * D, c.lane);
    }
    for (int e = gt; e < DEPTH * 1024; e += NGT) {
        const int L = e >> 10, gp = e & 1023, g = gp >> 6, p = gp & 63; unsigned char* tb = c.ws + WS_TAB + (size_t)L * TAB_LAYER;
        const double lr = INF_(6, float)[L * 1024 + gp], li = INF_(7, float)[L * 1024 + gp], st = exp((double)INF_(8, float)[L * 16 + g]);
        const double mag = exp(lr * st), ar = mag * cos(li * st), ai = mag * sin(li * st);
        const double mag64 = exp(64.0 * lr * st), ar64 = mag64 * cos(64.0 * li * st), ai64 = mag64 * sin(64.0 * li * st);
        ((f32x4*)(tb + TAB_LAM))[gp] = (f32x4){(float)ar, (float)ai, (float)ar64, (float)ai64};
        const double den = lr * lr + li * li, nr = ar - 1.0, ni = ai, cr = (nr * lr + ni * li) / den, ci = (ni * lr - nr * li) / den;
        const float* bre = INF_(9, float) + ((size_t)L * 1024 + gp) * 16; const float* bim = INF_(10, float) + ((size_t)L * 1024 + gp) * 16;
        float* BBR = (float*)(tb + TAB_BBR); float* BBI = (float*)(tb + TAB_BBI);
        for (int q = 0; q < 16; ++q) { const double br = bre[q], bi = bim[q]; BBR[(g * 16 + q) * 64 + p] = (float)(cr * br - ci * bi); BBI[(g * 16 + q) * 64 + p] = (float)(cr * bi + ci * br); }
        const float* cre = INF_(11, float) + (size_t)L * 16384 + g * 1024; const float* cim = INF_(12, float) + (size_t)L * 16384 + g * 1024;
        unsigned* CM = (unsigned*)(tb + TAB_CM);
        for (int co = 0; co < 16; ++co) CM[(g * 16 + co) * 64 + p] = pkbf(cre[co * 64 + p], -cim[co * 64 + p]);
    }
    for (int e = gt; e < DEPTH * 256; e += NGT) { const int L = e >> 8, j = e & 255; const float lam = INF_(22, float)[e];
        ((float*)(c.ws + WS_TAB + (size_t)L * TAB_LAYER + TAB_SP))[j] = (float)log1p(exp(-(double)lam)); }
    {
        const f32x4* p4 = (const f32x4*)INF_(1, float); u32x4* pb = (u32x4*)(c.ws + WS_PB);
        for (int e = gt; e < DEPTH * M * 256 / 8; e += NGT) { const f32x4 a = p4[2 * e], b = p4[2 * e + 1]; pb[e] = (u32x4){pkbf(a[0], a[1]), pkbf(a[2], a[3]), pkbf(b[0], b[1]), pkbf(b[2], b[3])}; }
    }
}

struct S5State { float bbr[2][16], bbi[2][16], ar[2], ai[2], xr[2], xi[2]; };
__device__ __forceinline__ void s5_load_params(const Ctx& c, int L, S5State& S) {
    const unsigned char* tb = c.ws + WS_TAB + (size_t)L * TAB_LAYER;
    unsigned lo_ = (unsigned)c.lane * 4u; asm volatile("" : "+v"(lo_));
#pragma unroll
    for (int s = 0; s < 2; ++s) { const int g = 2 * c.wave + s; const f32x4 lm = ((const f32x4*)(tb + TAB_LAM))[g * 64 + c.lane]; S.ar[s] = lm[0]; S.ai[s] = lm[1];
        const unsigned char* pr = tb + TAB_BBR + (size_t)g * 4096 + lo_; const unsigned char* pi = tb + TAB_BBI + (size_t)g * 4096 + lo_;
#pragma unroll
        for (int q = 0; q < 16; ++q) { S.bbr[s][q] = *(const float*)(pr + q * 256); S.bbi[s][q] = *(const float*)(pi + q * 256); } }
}
__device__ __forceinline__ void s5_load_u(const Ctx& c, int chunk) {
    const u32x4* src = (const u32x4*)(c.ws + WS_U + (size_t)chunk * 64 * 512);
#pragma unroll
    for (int i = 0; i < 4; ++i) *(LAS u32x4*)(c.lds + (c.tid + i * 512) * 16) = src[c.tid + i * 512];
}
__device__ __forceinline__ void s5_step(const Ctx& c, S5State& S, int t) {
#pragma unroll
    for (int s = 0; s < 2; ++s) { const int g = 2 * c.wave + s;
        const u32x4 ua = *(const LAS u32x4*)(c.lds + t * 512 + g * 32), ub = *(const LAS u32x4*)(c.lds + t * 512 + g * 32 + 16);
        float uu[16];
#pragma unroll
        for (int q = 0; q < 4; ++q) { uu[2 * q] = bflo(ua[q]); uu[2 * q + 1] = bfhi(ua[q]); uu[8 + 2 * q] = bflo(ub[q]); uu[8 + 2 * q + 1] = bfhi(ub[q]); }
        float br = 0.f, bi = 0.f;
#pragma unroll
        for (int q = 0; q < 16; ++q) { br = fmaf(S.bbr[s][q], uu[q], br); bi = fmaf(S.bbi[s][q], uu[q], bi); }
        const float nr = S.ar[s] * S.xr[s] - S.ai[s] * S.xi[s] + br, ni = S.ar[s] * S.xi[s] + S.ai[s] * S.xr[s] + bi;
        S.xr[s] = nr; S.xi[s] = ni; }
}
__device__ __forceinline__ void s5_pass1_unit(const Ctx& c, int L, int chunk) {
    S5State S; s5_load_params(c, L, S); s5_load_u(c, chunk);
    S.xr[0] = S.xi[0] = S.xr[1] = S.xi[1] = 0.f;
    __syncthreads();
#pragma unroll 1
    for (int t = 0; t < 64; ++t) s5_step(c, S, t);
    f32x2_t* out = (f32x2_t*)(c.ws + WS_S5S) + (size_t)chunk * 1024;
#pragma unroll
    for (int s = 0; s < 2; ++s) out[(2 * c.wave + s) * 64 + c.lane] = (f32x2_t){S.xr[s], S.xi[s]};
    __syncthreads();
}
constexpr int S5_YP = 32768, S5_YP_STRIDE = 264, S5_XS = S5_YP + 64 * S5_YP_STRIDE * 2;
static_assert(S5_XS + 8 * 8192 <= LDS_BYTES, "s5 lds");
__device__ __forceinline__ void s5_pass2_unit(const Ctx& c, int L, int chunk) {
    const unsigned char* tb = c.ws + WS_TAB + (size_t)L * TAB_LAYER;
    S5State S; s5_load_params(c, L, S); s5_load_u(c, chunk);
    int lane = c.lane; asm volatile("" : "+v"(lane));
    const int w = c.wave, fr = lane & 15, fq = lane >> 4;
    {
        const int cs = chunk & 31; const f32x2_t* sp = (const f32x2_t*)(c.ws + WS_S5S) + (size_t)(chunk - cs) * 1024;
#pragma unroll
        for (int s = 0; s < 2; ++s) { const int gp = (2 * w + s) * 64 + lane; const f32x4 lm = ((const f32x4*)(tb + TAB_LAM))[gp]; float xr = 0.f, xi = 0.f;
            for (int k = 0; k < cs; ++k) { const f32x2_t sv = sp[(size_t)k * 1024 + gp]; const float nr = lm[2] * xr - lm[3] * xi + sv[0], ni = lm[2] * xi + lm[3] * xr + sv[1]; xr = nr; xi = ni; }
            S.xr[s] = xr; S.xi[s] = xi; }
    }
    const unsigned char* cmp = tb + TAB_CM + ((size_t)((2 * w) * 16 + fr) * 128 + 8 * fq) * 2;
    const float* dsk = INF_(13, float) + L * 256;
    float dk[2]; dk[0] = dsk[(2 * w) * 16 + fr]; dk[1] = dsk[(2 * w + 1) * 16 + fr];
    __syncthreads();
    LAS unsigned char* xs = c.lds + S5_XS + w * 8192;
#pragma unroll 1
    for (int sb = 0; sb < 4; ++sb) {
#pragma unroll 1
        for (int tt = 0; tt < 16; ++tt) {
            s5_step(c, S, sb * 16 + tt);
#pragma unroll
            for (int s = 0; s < 2; ++s) *(LAS unsigned*)(xs + (tt * 2 + s) * 256 + lane * 4) = pkbf(S.xr[s], S.xi[s]);
        }
#pragma unroll
        for (int s = 0; s < 2; ++s) {
            f32x4 acc = {0.f, 0.f, 0.f, 0.f};
#pragma unroll
            for (int ks = 0; ks < 4; ++ks) { const bf16x8 af = *(const LAS bf16x8*)(xs + (fr * 2 + s) * 256 + (32 * ks + 8 * fq) * 2);
                const bf16x8 cmf = *(const bf16x8*)(cmp + s * 4096 + ks * 64);
                acc = __builtin_amdgcn_mfma_f32_16x16x32_bf16(af, cmf, acc, 0, 0, 0); }
            const int g = 2 * w + s;
#pragma unroll
            for (int i = 0; i < 4; ++i) { const int t = sb * 16 + 4 * fq + i; const float uv = bf2f(*(const LAS unsigned short*)(c.lds + t * 512 + (g * 16 + fr) * 2));
                const float y = gelu_tanh(acc[i] + dk[s] * uv);
                *(LAS unsigned short*)(c.lds + S5_YP + (t * S5_YP_STRIDE + g * 16 + fr) * 2) = (unsigned short)(pkbf(y, 0.f) & 0xffffu); }
        }
    }
    __syncthreads();
    {
        const bf16_t* GT = (const bf16_t*)(c.ws + WS_W + (size_t)L * W_LAYER + OW_GLU);
        f32x4 z[4][2];
#pragma unroll
        for (int tb_ = 0; tb_ < 4; ++tb_) { z[tb_][0] = (f32x4){0.f, 0.f, 0.f, 0.f}; z[tb_][1] = (f32x4){0.f, 0.f, 0.f, 0.f}; }
#pragma unroll 1
        for (int ks = 0; ks < 8; ++ks) {
            bf16x8 bfr[2];
#pragma unroll
            for (int nt = 0; nt < 2; ++nt) bfr[nt] = *(const bf16x8*)(GT + (size_t)(32 * w + 16 * nt + fr) * 256 + 32 * ks + 8 * fq);
#pragma unroll
            for (int tb_ = 0; tb_ < 4; ++tb_) { const bf16x8 af = *(const LAS bf16x8*)(c.lds + S5_YP + ((16 * tb_ + fr) * S5_YP_STRIDE + 32 * ks + 8 * fq) * 2);
#pragma unroll
                for (int nt = 0; nt < 2; ++nt) z[tb_][nt] = __builtin_amdgcn_mfma_f32_16x16x32_bf16(af, bfr[nt], z[tb_][nt], 0, 0, 0); }
        }
        const float* bg = INF_(15, float) + L * 256; bf16_t* Y = (bf16_t*)(c.ws + WS_Y);
#pragma unroll
        for (int nt = 0; nt < 2; ++nt) { const int n = 32 * w + 16 * nt + fr; const float bgn = bg[n];
#pragma unroll
            for (int tb_ = 0; tb_ < 4; ++tb_)
#pragma unroll
                for (int i = 0; i < 4; ++i) { const int t = 16 * tb_ + 4 * fq + i; const float yp = bf2f(*(const LAS unsigned short*)(c.lds + S5_YP + (t * S5_YP_STRIDE + n) * 2));
                    Y[(size_t)(chunk * 64 + t) * D + n] = (bf16_t)(pkbf(yp * sigmoidf_(z[tb_][nt][i] + bgn), 0.f) & 0xffffu); } }
    }
    __syncthreads();
}

__device__ __forceinline__ void rg_pass1_unit(const Ctx& c, int L, int u) {
    int tid_ = c.tid; asm volatile("" : "+v"(tid_));
    const int j = tid_ & 255, half = tid_ >> 8, m0 = u * 64, tl0 = half * 32;
    const float* X = (const float*)(c.ws + WS_XRG);
    const float* cw = INF_(16, float) + L * 1024; const float cb = INF_(17, float)[L * 256 + j];
    const float w0 = cw[j], w1 = cw[256 + j], w2 = cw[512 + j], w3 = cw[768 + j];
    LAS float* xc = (LAS float*)c.lds;
    {
        const int mm = m0 + tl0; const bool seq_start = ((mm & 2047) == 0);
        float x0 = seq_start ? 0.f : X[(size_t)(mm - 3) * 256 + j], x1 = seq_start ? 0.f : X[(size_t)(mm - 2) * 256 + j], x2 = seq_start ? 0.f : X[(size_t)(mm - 1) * 256 + j];
        for (int t = 0; t < 32; ++t) { const float x3 = X[(size_t)(mm + t) * 256 + j]; xc[(tl0 + t) * 256 + j] = cb + w0 * x0 + w1 * x1 + w2 * x2 + w3 * x3; x0 = x1; x1 = x2; x2 = x3; }
    }
    const int hb = j >> 5, jj = j & 31;
    float wa[32], wx[32];
    { const float* WA = INF_(18, float) + (size_t)L * 8192 + hb * 1024; const float* WX = INF_(20, float) + (size_t)L * 8192 + hb * 1024;
#pragma unroll
      for (int i = 0; i < 32; ++i) { wa[i] = WA[i * 32 + jj]; wx[i] = WX[i * 32 + jj]; } }
    const float ba = INF_(19, float)[L * 256 + j], bx = INF_(21, float)[L * 256 + j];
    const float sp = ((const float*)(c.ws + WS_TAB + (size_t)L * TAB_LAYER + TAB_SP))[j];
    float* RA = (float*)(c.ws + WS_RA); float* RB = (float*)(c.ws + WS_RB);
    __syncthreads();
    for (int t = 0; t < 32; ++t) { const int tl = tl0 + t; float ra = ba, rx = bx;
#pragma unroll
        for (int i4 = 0; i4 < 8; ++i4) { const f32x4 xv = *(const LAS f32x4*)(xc + tl * 256 + hb * 32 + 4 * i4);
#pragma unroll
            for (int q = 0; q < 4; ++q) { ra = fmaf(xv[q], wa[4 * i4 + q], ra); rx = fmaf(xv[q], wx[4 * i4 + q], rx); } }
        const float r = sigmoidf_(ra), ig = sigmoidf_(rx), xcv = xc[tl * 256 + j];
        const float log_a = -8.0f * r * sp, a = expf(log_a), mult = sqrtf(-expm1f(2.0f * log_a));
        RA[(size_t)(m0 + tl) * 256 + j] = a; RB[(size_t)(m0 + tl) * 256 + j] = mult * (ig * xcv); }
    __syncthreads();
}
__device__ __forceinline__ void rg_scan_unit(const Ctx& c, int u) {
    int tid_ = c.tid; asm volatile("" : "+v"(tid_));
    const int b = u >> 3, hb = u & 7, jj = tid_ & 31, seg = tid_ >> 5, j = hb * 32 + jj;
    const float* RA = (const float*)(c.ws + WS_RA) + (size_t)(b * 2048 + seg * 128) * 256 + j; const float* RB = (const float*)(c.ws + WS_RB) + (size_t)(b * 2048 + seg * 128) * 256 + j;
    float A = 1.f, Hh = 0.f;
#pragma unroll 8
    for (int t = 0; t < 128; ++t) { const float a = RA[(size_t)t * 256], bv = RB[(size_t)t * 256]; Hh = fmaf(a, Hh, bv); A *= a; }
    LAS float* ex = (LAS float*)c.lds;
    ex[(seg * 32 + jj) * 2] = A; ex[(seg * 32 + jj) * 2 + 1] = Hh;
    __syncthreads();
    float h = 0.f;
    for (int s = 0; s < seg; ++s) h = fmaf(ex[(s * 32 + jj) * 2], h, ex[(s * 32 + jj) * 2 + 1]);
    const bf16_t* G = (const bf16_t*)(c.ws + WS_GRG) + (size_t)(b * 2048 + seg * 128) * 256 + j; bf16_t* Y = (bf16_t*)(c.ws + WS_Y) + (size_t)(b * 2048 + seg * 128) * D + 256 + j;
#pragma unroll 8
    for (int t = 0; t < 128; ++t) { const float a = RA[(size_t)t * 256], bv = RB[(size_t)t * 256]; h = fmaf(a, h, bv);
        Y[(size_t)t * D] = (bf16_t)(pkbf(h * gelu_tanh(bf2f(G[(size_t)t * 256])), 0.f) & 0xffffu); }
    __syncthreads();
}

constexpr int IDX_STRIDE = 2064;
static_assert(16 * IDX_STRIDE * 4 <= LDS_BYTES, "indexer lds");
template <int NR>
__device__ __forceinline__ void select_row(const LAS float* row, int nk, int lane, unsigned* selrow) {
    float v[NR];
#pragma unroll
    for (int r = 0; r < NR; ++r) { const int idx = 64 * r + lane; v[r] = idx < nk ? row[idx] : -INFINITY; }
    float mx = -INFINITY, mn = INFINITY;
#pragma unroll
    for (int r = 0; r < NR; ++r) { mx = fmaxf(mx, v[r]); mn = fminf(mn, v[r] == -INFINITY ? INFINITY : v[r]); }
    mx = wave_max(mx); mn = wave_min(mn);
    float lo = mn, hi = mx, thr = 0.f; bool tie = false; int cgt = 0;
    {
        int ch = 0;
#pragma unroll
        for (int r = 0; r < NR; ++r) ch += (v[r] >= hi) ? 1 : 0;
        ch = wave_sum_i(ch);
        if (ch >= 256) { tie = true; lo = hi; cgt = 0; }
        else {
            cgt = ch;
            for (;;) {
                const float mid = lo + 0.5f * (hi - lo);
                if (!(mid > lo) || !(mid < hi)) { tie = true; break; }
                int cm = 0;
#pragma unroll
                for (int r = 0; r < NR; ++r) cm += (v[r] >= mid) ? 1 : 0;
                cm = wave_sum_i(cm);
                if (cm == 256) { thr = mid; break; }
                if (cm > 256) lo = mid; else { hi = mid; cgt = cm; }
            }
        }
    }
    unsigned long long mine = 0ull;
    if (!tie) {
#pragma unroll
        for (int r = 0; r < NR; ++r) { const unsigned long long mk = __ballot(v[r] >= thr); if (lane == r) mine = mk; }
    } else {
        int need = 256 - cgt, base = 0;
#pragma unroll
        for (int r = 0; r < NR; ++r) { const unsigned long long tm = __ballot(v[r] == lo); const int rank = base + __builtin_popcountll(tm & ((1ull << lane) - 1ull));
            const unsigned long long mk = __ballot(v[r] > lo || (v[r] == lo && rank < need)); base += __builtin_popcountll(tm); if (lane == r) mine = mk; }
    }
    if (lane < 32) *(unsigned long long*)(selrow + 2 * lane) = mine;
}
__device__ __forceinline__ void idx_unit(const Ctx& c, int b, int qt) {
    int lane = c.lane; asm volatile("" : "+v"(lane));
    const int w = c.wave, fr = lane & 15, fq = lane >> 4, t0 = 16 * qt, nkb = qt + 1, nk = t0 + 16;
    const size_t mb = (size_t)b * 2048;
    const bf16_t* QI = (const bf16_t*)(c.ws + WS_QI); const bf16_t* KI = (const bf16_t*)(c.ws + WS_KI); const float* WI = (const float*)(c.ws + WS_WI);
    bf16x8 af[4][2][2]; float wt[4][8];
#pragma unroll
    for (int G = 0; G < 4; ++G) {
#pragma unroll
        for (int hl = 0; hl < 2; ++hl)
#pragma unroll
            for (int ks = 0; ks < 2; ++ks) af[G][hl][ks] = *(const bf16x8*)(QI + (mb + t0 + 4 * G + (fr >> 2)) * 512 + 64 * (4 * hl + (fr & 3)) + 32 * ks + 8 * fq);
#pragma unroll
        for (int h = 0; h < 8; ++h) wt[G][h] = WI[(mb + t0 + 4 * G + fq) * 8 + h] * IDX_SCALE;
    }
    LAS float* sc = (LAS float*)c.lds;
    for (int kb = w; kb < nkb; kb += 8) {
        bf16x8 bfr[2];
#pragma unroll
        for (int ks = 0; ks < 2; ++ks) bfr[ks] = *(const bf16x8*)(KI + (mb + 16 * kb + fr) * 64 + 32 * ks + 8 * fq);
        const int key = 16 * kb + fr;
#pragma unroll
        for (int G = 0; G < 4; ++G) {
            f32x4 lo = {0.f, 0.f, 0.f, 0.f}, hi = {0.f, 0.f, 0.f, 0.f};
            lo = __builtin_amdgcn_mfma_f32_16x16x32_bf16(af[G][0][0], bfr[0], lo, 0, 0, 0); lo = __builtin_amdgcn_mfma_f32_16x16x32_bf16(af[G][0][1], bfr[1], lo, 0, 0, 0);
            hi = __builtin_amdgcn_mfma_f32_16x16x32_bf16(af[G][1][0], bfr[0], hi, 0, 0, 0); hi = __builtin_amdgcn_mfma_f32_16x16x32_bf16(af[G][1][1], bfr[1], hi, 0, 0, 0);
            float s = 0.f;
#pragma unroll
            for (int i = 0; i < 4; ++i) { s = fmaf(fmaxf(lo[i], 0.f), wt[G][i], s); s = fmaf(fmaxf(hi[i], 0.f), wt[G][4 + i], s); }
            const int q = 4 * G + fq;
            if (key > t0 + q) s = -INFINITY;
            sc[q * IDX_STRIDE + key] = s;
        }
    }
    __syncthreads();
    unsigned* SEL = (unsigned*)(c.ws + WS_SEL);
    const int nr = (nk + 63) >> 6;
#pragma unroll
    for (int qq = 0; qq < 2; ++qq) { const int q = 2 * w + qq; unsigned* selrow = SEL + (mb + t0 + q) * 64; const LAS float* row = sc + q * IDX_STRIDE;
        if (nr <= 8) select_row<8>(row, nk, lane, selrow); else if (nr <= 16) select_row<16>(row, nk, lane, selrow);
        else if (nr <= 24) select_row<24>(row, nk, lane, selrow); else select_row<32>(row, nk, lane, selrow); }
    __syncthreads();
}
__device__ __forceinline__ void maskfill_unit(const Ctx& c, int b, int qt) {
#pragma unroll
    for (int qq = 0; qq < 2; ++qq) { const int t = 16 * qt + 2 * c.wave + qq; unsigned* selrow = (unsigned*)(c.ws + WS_SEL) + ((size_t)b * 2048 + t) * 64;
        if (c.lane < 32) { const int k0 = 64 * c.lane; unsigned long long mk = 0ull; if (k0 + 63 <= t) mk = ~0ull; else if (k0 <= t) mk = (1ull << (t - k0 + 1)) - 1ull;
            *(unsigned long long*)(selrow + 2 * c.lane) = mk; } }
}

__device__ __forceinline__ void attn_unit(const Ctx& c, int b, int g, int qb) {
    int lane = c.lane; asm volatile("" : "+v"(lane));
    const int w = c.wave, r32 = lane & 31, hh = lane >> 5, head = 4 * g + (w & 3), tq0 = 64 * qb + 32 * (w >> 2), tq = tq0 + r32;
    const size_t mb = (size_t)b * 2048;
    const bf16_t* Q = (const bf16_t*)(c.ws + WS_Q); const bf16_t* KB = (const bf16_t*)(c.ws + WS_KB); const bf16_t* VT = (const bf16_t*)(c.ws + WS_VT) + (size_t)(b * 2 + g) * 64 * 2048;
    const unsigned* SEL = (const unsigned*)(c.ws + WS_SEL) + (mb + tq) * 64;
    bf16x8 qf[4];
#pragma unroll
    for (int ks = 0; ks < 4; ++ks) qf[ks] = *(const bf16x8*)(Q + (mb + tq) * 512 + 64 * head + 16 * ks + 8 * hh);
    f32x16 o0 = {}, o1 = {}; float mrun = -1e30f, lrun = 0.f;
    const int ntiles = (tq0 >> 5) + 1;
    for (int kt = 0; kt < ntiles; ++kt) {
        f32x16 s = {};
#pragma unroll
        for (int ks = 0; ks < 4; ++ks) { const bf16x8 kf = *(const bf16x8*)(KB + (mb + 32 * kt + r32) * 128 + 64 * g + 16 * ks + 8 * hh);
            s = __builtin_amdgcn_mfma_f32_32x32x16_bf16(kf, qf[ks], s, 0, 0, 0); }
        const unsigned mw = SEL[kt];
        float rmax = -INFINITY;
#pragma unroll
        for (int i = 0; i < 16; ++i) { const int kl = (i & 3) + 8 * (i >> 2) + 4 * hh; if (!((mw >> kl) & 1u)) s[i] = -INFINITY; rmax = fmaxf(rmax, s[i]); }
        rmax = xhalf_max(rmax);
        const float mnew = fmaxf(mrun, rmax), alpha = exp2f(mrun - mnew);
        float rs = 0.f; float p[16];
#pragma unroll
        for (int i = 0; i < 16; ++i) { p[i] = exp2f(s[i] - mnew); rs += p[i]; }
        rs = xhalf_sum(rs);
        lrun = lrun * alpha + rs; mrun = mnew;
#pragma unroll
        for (int i = 0; i < 16; ++i) { o0[i] *= alpha; o1[i] *= alpha; }
#pragma unroll
        for (int sN = 0; sN < 2; ++sN) {
            bf16x8 pf;
            { const unsigned a0 = pkbf(p[8 * sN + 0], p[8 * sN + 1]), a1 = pkbf(p[8 * sN + 2], p[8 * sN + 3]), a2 = pkbf(p[8 * sN + 4], p[8 * sN + 5]), a3 = pkbf(p[8 * sN + 6], p[8 * sN + 7]);
              const u32x4 pw = {a0, a1, a2, a3}; pf = __builtin_bit_cast(bf16x8, pw); }
#pragma unroll
            for (int dt = 0; dt < 2; ++dt) {
                const bf16_t* vp = VT + (size_t)(32 * dt + r32) * 2048 + 32 * kt + 16 * sN + 4 * hh;
                const u32x2 va = *(const u32x2*)vp, vb = *(const u32x2*)(vp + 8);
                const u32x4 vw = {va[0], va[1], vb[0], vb[1]}; const bf16x8 vf = __builtin_bit_cast(bf16x8, vw);
                if (dt == 0) o0 = __builtin_amdgcn_mfma_f32_32x32x16_bf16(vf, pf, o0, 0, 0, 0); else o1 = __builtin_amdgcn_mfma_f32_32x32x16_bf16(vf, pf, o1, 0, 0, 0);
            }
        }
    }
    const float rl = 1.0f / lrun;
    bf16_t* Y = (bf16_t*)(c.ws + WS_Y) + (mb + tq) * D + 512 + 64 * head;
#pragma unroll
    for (int i4 = 0; i4 < 4; ++i4) { const int d = 8 * i4 + 4 * hh;
        *(u32x2*)(Y + d) = (u32x2){pkbf(o0[4 * i4] * rl, o0[4 * i4 + 1] * rl), pkbf(o0[4 * i4 + 2] * rl, o0[4 * i4 + 3] * rl)};
        *(u32x2*)(Y + 32 + d) = (u32x2){pkbf(o1[4 * i4] * rl, o1[4 * i4 + 1] * rl), pkbf(o1[4 * i4 + 2] * rl, o1[4 * i4 + 3] * rl)}; }
}

template <class Epi>
__device__ __forceinline__ void run_gemm(const Ctx& c, const bf16_t* A, const bf16_t* Bt, int N, int K, const Epi& E) {
    asm volatile("" : "+s"(K));
    pg8::Gemm g{A, Bt, M, N, K}; pg8::StaticOrder S; S.init(M, N, c.G, c.bid);
    pg8::gemm_phase<Epi, pg8::StaticOrder, true, true>(c.lds, g, S, E);
}

#ifndef DIS
#define DIS 0
#endif
template <int S>
__device__ __forceinline__ void run_stage(const Ctx& c, int L) {
    if constexpr ((DIS >> S) & 1) return;
    unsigned char* ws = c.ws; unsigned char* wl = ws + WS_W + (size_t)L * W_LAYER; float* H = c.a->out; bf16_t* HN = (bf16_t*)(ws + WS_HN);
    if constexpr (S == 10) { prologue(c); }
    if constexpr (S == 0) {
        EpiProj E{(bf16_t*)(ws + WS_U), (bf16_t*)(ws + WS_GRG), (bf16_t*)(ws + WS_Q), (bf16_t*)(ws + WS_KB), (bf16_t*)(ws + WS_VT), (bf16_t*)(ws + WS_QI), (bf16_t*)(ws + WS_KI),
                  (float*)(ws + WS_XRG), (float*)(ws + WS_WI), (const float*)(ws + WS_ROPE)};
        run_gemm(c, HN, (const bf16_t*)(wl + OW_IN), N_INP, D, E);
    }
    if constexpr (S == 1) {
        for (int u = c.bid; u < 1536; u += c.G) {
            if (u < 896) idx_unit(c, u & 7, 127 - (u >> 3));
            else if (u < 1024) maskfill_unit(c, (u - 896) & 7, (u - 896) >> 3);
            else if (u < 1280) s5_pass1_unit(c, L, u - 1024);
            else rg_pass1_unit(c, L, u - 1280);
        }
    }
    if constexpr (S == 2) {
        for (int u = c.bid; u < 832; u += c.G) {
            if (u < 512) { const int r = u >> 4, inner = u & 15; attn_unit(c, inner >> 1, inner & 1, u < 256 ? 31 - r : r - 16); }
            else if (u < 768) s5_pass2_unit(c, L, u - 512);
            else rg_scan_unit(c, u - 768);
        }
    }
    if constexpr (S == 3) { EpiResid E{H}; run_gemm(c, (const bf16_t*)(ws + WS_Y), (const bf16_t*)(wl + OW_OUT), D, D, E); }
    if constexpr (S == 4) ln_pass(c, H, INF_(24, float) + L * D, INF_(25, float) + L * D, HN);
    if constexpr (S == 5) { EpiStoreBf16 E{(bf16_t*)(ws + WS_Y), D}; run_gemm(c, (const bf16_t*)(ws + WS_PB) + (size_t)L * M * 256, (const bf16_t*)(wl + OW_PPROJ), D, 256, E); }
    if constexpr (S == 6) { EpiSwiglu E{(bf16_t*)(ws + WS_ACT)}; run_gemm(c, HN, (const bf16_t*)(wl + OW_UP), NUP, D, E); }
    if constexpr (S == 7) { EpiPle E{(bf16_t*)(ws + WS_Y)}; run_gemm(c, HN, (const bf16_t*)(wl + OW_GATE), D, D, E); }
    if constexpr (S == 8) { EpiDown E{H, (const bf16_t*)(ws + WS_Y)}; run_gemm(c, (const bf16_t*)(ws + WS_ACT), (const bf16_t*)(wl + OW_DOWN), D, DFF, E); }
    if constexpr (S == 9) ln_pass(c, H, INF_(30, float) + L * D, INF_(31, float) + L * D, HN);
}
constexpr int N_GROUPS = 1 + 8 * DEPTH;
#define MK_CTX() Ctx c; c.lds = (LAS unsigned char*)lds_raw; c.ldsg = lds_raw; \
        { unsigned long long kp = (unsigned long long)__builtin_amdgcn_kernarg_segment_ptr(); asm volatile("" : "+s"(kp)); c.a = (KArgs)kp; } \
        c.ws = c.a->ws; { int t = threadIdx.x; asm volatile("" : "+v"(t)); c.tid = t; } \
        c.lane = c.tid & 63; c.wave = __builtin_amdgcn_readfirstlane(c.tid >> 6); c.bid = blockIdx.x; c.G = gridDim.x;
#define MK_GROUP(k, body) do { if (lo <= (k) && (k) < hi) { { MK_CTX(); body; } if ((k) + 1 < hi) grid.sync(); } } while (0)
__global__ void __launch_bounds__(NTHREADS, 2) fwd_kernel(Args args) {
    extern __shared__ __attribute__((aligned(16))) unsigned char lds_raw[];
    cg::grid_group grid = cg::this_grid();
    const int lo = args.ph_lo, hi = args.ph_hi;
    MK_GROUP(0, run_stage<10>(c, 0));
#pragma unroll
    for (int L = 0; L < DEPTH; ++L) {
        const int k0 = 1 + 8 * L;
        MK_GROUP(k0 + 0, run_stage<0>(c, L));
        MK_GROUP(k0 + 1, run_stage<1>(c, L));
        MK_GROUP(k0 + 2, run_stage<2>(c, L));
        MK_GROUP(k0 + 3, run_stage<3>(c, L));
        MK_GROUP(k0 + 4, run_stage<4>(c, L));
        MK_GROUP(k0 + 5, run_stage<5>(c, L); run_stage<6>(c, L));
        MK_GROUP(k0 + 6, run_stage<7>(c, L); run_stage<8>(c, L));
        MK_GROUP(k0 + 7, run_stage<9>(c, L));
    }
}
#ifndef MK_PER_PHASE
#define MK_PER_PHASE 0
#endif
extern "C" void kernel_launch(void* const* d_in, const int* in_sizes, int n_in, void* d_out, int out_size, void* d_ws, size_t ws_size, hipStream_t stream) {
    static int grid = 0;
    if (grid == 0) {
        if (n_in != 32 || out_size != M * D || ws_size < WS_END) { fprintf(stderr, "kernel_launch: unexpected shapes (n_in %d out %d ws %zu)\n", n_in, out_size, ws_size); grid = -1; return; }
        int dev = 0, cus = 0, per_cu = 0;
        (void)hipGetDevice(&dev); (void)hipDeviceGetAttribute(&cus, hipDeviceAttributeMultiprocessorCount, dev);
        (void)hipFuncSetAttribute((const void*)fwd_kernel, hipFuncAttributeMaxDynamicSharedMemorySize, LDS_BYTES);
        (void)hipOccupancyMaxActiveBlocksPerMultiprocessor(&per_cu, (const void*)fwd_kernel, NTHREADS, LDS_BYTES);
        if (per_cu < 1) { fprintf(stderr, "kernel_launch: occupancy query says %d blocks/CU\n", per_cu); }
        (void)hipGetLastError();
        grid = cus;
    }
    if (grid < 0) return;
    Args a{};
    for (int i = 0; i < 32; ++i) a.in[i] = d_in[i];
    a.out = (float*)d_out; a.ws = (unsigned char*)d_ws;
#if MK_PER_PHASE
    for (int ph = 0; ph < N_GROUPS; ++ph) { a.ph_lo = ph; a.ph_hi = ph + 1; hipLaunchKernelGGL(fwd_kernel, dim3(grid), dim3(NTHREADS), LDS_BYTES, stream, a); }
#else
    a.ph_lo = 0; a.ph_hi = N_GROUPS;
    void* kargs[] = {&a};
    hipError_t e = hipLaunchCooperativeKernel((const void*)fwd_kernel, dim3(grid), dim3(NTHREADS), kargs, LDS_BYTES, stream);
    if (e != hipSuccess) fprintf(stderr, "cooperative launch failed: %s (grid %d)\n", hipGetErrorString(e), grid);
#endif
}
```

```cpp
#include <hip/hip_runtime.h>
#include <hip/hip_cooperative_groups.h>
#include <cstdio>
#include <cstdint>
namespace cg = cooperative_groups;
namespace pg8 {
#define PG8_LAS __attribute__((address_space(3)))
typedef unsigned short bf16_t;
typedef short bf16x8 __attribute__((ext_vector_type(8)));
typedef float f32x4 __attribute__((ext_vector_type(4)));
typedef unsigned u32x4 __attribute__((ext_vector_type(4)));
constexpr int BM = 256, BK = 64, HALF = 128, HTB = HALF * BK * 2  , STAGE_BYTES = 8 * HTB, NXCD = 8, WGM = 8;

__host__ __device__ __forceinline__ int lds_byte(int r, int c) { const int st = (r >> 4) * 2 + (c >> 5), rr = r & 15, cc = c & 31, ob = rr * 64 + cc * 2; return st * 1024 + (ob ^ (((ob >> 9) & 1) << 5)); }
__host__ __device__ __forceinline__ void stage_rc(int b, int& R, int& C) { const int st = b / 1024, sb = b % 1024, swz = sb ^ (((sb >> 9) & 1) << 5); R = (st >> 1) * 16 + swz / 64; C = (st & 1) * 32 + (swz % 64) / 2; }
__host__ __device__ __forceinline__ int perm32(int rho) { const int n = rho >> 4, i = rho & 15; return 8 * (i >> 2) + 4 * n + (i & 3); }

struct Unit { int pm, pn; };
struct Gemm { const bf16_t* A; const bf16_t* Bt; int M, N, K; };

struct StaticOrder {
    int nM, nN, nwg, G, c;
    __host__ __device__ void init(int M, int N, int G_, int c_) { nM = M / BM; nN = N / BM; nwg = nM * nN; G = G_; c = c_; }
    __host__ __device__ bool next(int i, Unit& u) const {
        const long L = (long)i * G + c; if (L >= nwg) return false;
        int wgid = (int)L; { const int q = nwg / NXCD, r = nwg % NXCD, xcd = wgid % NXCD, off = wgid / NXCD; wgid = (xcd < r ? xcd * (q + 1) : r * (q + 1) + (xcd - r) * q) + off; }
        const int nig = WGM * nN, gid = wgid / nig, fm = gid * WGM, gsz = (nM - fm) < WGM ? (nM - fm) : WGM;
        u.pm = fm + ((wgid % nig) % gsz); u.pn = (wgid % nig) / gsz; return true;
    }
    __device__ __forceinline__ void a_ready(const Unit&) const {}
    __device__ __forceinline__ void done(const Unit&) const {}
};

template <class Epi, class Sched, bool ALIGN_EPI = false, bool SP2 = false>
__device__ __forceinline__ void gemm_phase(PG8_LAS unsigned char* lds, const Gemm g, const Sched& S, const Epi& E) {
    int tid = threadIdx.x; asm volatile("" : "+v"(tid));
    const int wid = __builtin_amdgcn_readfirstlane(tid >> 6), lane = tid & 63, wr = wid >> 2, wc = wid & 3, fr = lane & 15, fq = lane >> 4;
    const int K = g.K, nt = K / BK;
    unsigned voffA[2], voffB[2];
#pragma unroll
    for (int i = 0; i < 2; ++i) { int R, C; stage_rc(tid * 16 + i * 8192, R, C); const int Rb = Epi::PERM ? ((R & ~31) + perm32(R & 31)) : R;
        voffA[i] = (unsigned)(R * K + C) * 2u; voffB[i] = (unsigned)(Rb * K + C) * 2u; }
    const size_t kstep = (size_t)(BK * 2);
    const size_t hstep = (size_t)HALF * K * 2;
    const size_t tstep = 2 * hstep;
    const unsigned ldsw = (unsigned)wid * 1024u;
    const int aoff = lds_byte(wr * 64 + fr, fq * 8), boff = lds_byte(wc * 32 + fr, fq * 8);
#define PG8_SA(b, h) (((b) * 2 + (h)) * HTB)
#define PG8_SB(b, h) ((4 + (b) * 2 + (h)) * HTB)
#define PG8_STAGE(bufoff, gbase, voff) do { _Pragma("unroll") for (int _i = 0; _i < 2; ++_i) \
        __builtin_amdgcn_global_load_lds((const unsigned*)((const char*)(gbase) + (voff)[_i]), (PG8_LAS unsigned*)(lds + (bufoff) + ldsw + _i * 8192), 16, 0, 0); } while (0)
#define PG8_LDA(dst, b, h) do { _Pragma("unroll") for (int m = 0; m < 4; ++m) _Pragma("unroll") for (int k = 0; k < 2; ++k) dst[m][k] = *(const PG8_LAS bf16x8*)(lds + PG8_SA(b, h) + aoff + m * 2048 + k * 1024); } while (0)
#define PG8_LDB(dst, b, h) do { _Pragma("unroll") for (int n = 0; n < 2; ++n) _Pragma("unroll") for (int k = 0; k < 2; ++k) dst[n][k] = *(const PG8_LAS bf16x8*)(lds + PG8_SB(b, h) + boff + n * 2048 + k * 1024); } while (0)
#define PG8_MMA(ai, bj, At, Bt) do { __builtin_amdgcn_s_setprio(1); _Pragma("unroll") for (int m = 0; m < 4; ++m) _Pragma("unroll") for (int n = 0; n < 2; ++n) _Pragma("unroll") for (int k = 0; k < 2; ++k) \
        acc[ai][bj][m][n] = __builtin_amdgcn_mfma_f32_16x16x32_bf16(Bt[n][k], At[m][k], acc[ai][bj][m][n], 0, 0, 0); __builtin_amdgcn_s_setprio(0); } while (0)
#define PG8_WAIT_V(n) asm volatile("s_waitcnt vmcnt(" #n ")" ::: "memory")
#define PG8_WAIT_L(n) asm volatile("s_waitcnt lgkmcnt(" #n ")" ::: "memory")
#define PG8_BAR __builtin_amdgcn_s_barrier()
#define PG8_SCHED __builtin_amdgcn_sched_barrier(0)
    Unit cur, nxt; int ui = 0;
    if (!S.next(0, cur)) return;
    f32x4 acc[2][2][4][2];
#pragma unroll
    for (int a = 0; a < 2; ++a)
#pragma unroll
        for (int b = 0; b < 2; ++b)
#pragma unroll
            for (int m = 0; m < 4; ++m)
#pragma unroll
                for (int n = 0; n < 2; ++n) acc[a][b][m][n] = (f32x4){0.f, 0.f, 0.f, 0.f};
    bf16x8 At[4][2], B0[2][2], B1[2][2];
    const char* cA = (const char*)g.A + (size_t)cur.pm * tstep; const char* cB = (const char*)g.Bt + (size_t)cur.pn * tstep;
    S.a_ready(cur);
    if constexpr (SP2) {
        PG8_STAGE(PG8_SB(0, 0), cB, voffB); PG8_STAGE(PG8_SB(0, 1), cB + hstep, voffB); PG8_STAGE(PG8_SA(0, 0), cA, voffA); PG8_STAGE(PG8_SA(0, 1), cA + hstep, voffA);
        if (wr == 1) PG8_BAR;
        PG8_WAIT_V(2); PG8_BAR;
        PG8_STAGE(PG8_SB(1, 0), cB + kstep, voffB); PG8_STAGE(PG8_SA(1, 0), cA + kstep, voffA); PG8_STAGE(PG8_SB(1, 1), cB + hstep + kstep, voffB);
        PG8_WAIT_V(6); PG8_BAR;
    } else {
        PG8_STAGE(PG8_SB(0, 0), cB, voffB); PG8_STAGE(PG8_SA(0, 0), cA, voffA); PG8_STAGE(PG8_SB(0, 1), cB + hstep, voffB); PG8_STAGE(PG8_SA(0, 1), cA + hstep, voffA);
        if (wr == 1) PG8_BAR;
        PG8_WAIT_V(4); PG8_BAR;
        PG8_STAGE(PG8_SB(1, 0), cB + kstep, voffB); PG8_STAGE(PG8_SA(1, 0), cA + kstep, voffA); PG8_STAGE(PG8_SB(1, 1), cB + hstep + kstep, voffB);
        PG8_WAIT_V(6); PG8_BAR;
    }
    for (;;) {
        const bool has_next = S.next(ui + 1, nxt);
        const char* nA = has_next ? (const char*)g.A + (size_t)nxt.pm * tstep : cA; const char* nB = has_next ? (const char*)g.Bt + (size_t)nxt.pn * tstep : cB;
        for (int t = 0; t < nt; t += 2) {
            const bool last = (t == nt - 2);
            const char* a1 = cA + (size_t)(t + 1) * kstep;
            const char* a2 = last ? nA : cA + (size_t)(t + 2) * kstep; const char* b2 = last ? nB : cB + (size_t)(t + 2) * kstep;
            const char* a3 = a2 + kstep; const char* b3 = b2 + kstep;
            if (last && has_next) S.a_ready(nxt);
            if constexpr (SP2) {
            PG8_LDB(B0, 0, 0); PG8_LDB(B1, 0, 1); PG8_SCHED; PG8_LDA(At, 0, 0); PG8_STAGE(PG8_SA(1, 1), a1 + hstep, voffA);
            PG8_WAIT_V(8); PG8_WAIT_L(0); PG8_BAR; PG8_MMA(0, 0, At, B0); PG8_MMA(0, 1, At, B1); PG8_BAR; PG8_SCHED;
            PG8_LDA(At, 0, 1); PG8_STAGE(PG8_SB(0, 0), b2, voffB); PG8_STAGE(PG8_SB(0, 1), b2 + hstep, voffB); PG8_STAGE(PG8_SA(0, 0), a2, voffA);
            PG8_WAIT_V(8); PG8_WAIT_L(0); PG8_BAR; PG8_MMA(1, 0, At, B0); PG8_MMA(1, 1, At, B1); PG8_BAR; PG8_SCHED;
            PG8_LDB(B0, 1, 0); PG8_LDB(B1, 1, 1); PG8_SCHED; PG8_LDA(At, 1, 0); PG8_STAGE(PG8_SA(0, 1), a2 + hstep, voffA);
            PG8_WAIT_V(8); PG8_WAIT_L(0); PG8_BAR; PG8_MMA(0, 0, At, B0); PG8_MMA(0, 1, At, B1); PG8_BAR; PG8_SCHED;
            PG8_LDA(At, 1, 1); PG8_STAGE(PG8_SB(1, 0), b3, voffB); PG8_STAGE(PG8_SB(1, 1), b3 + hstep, voffB); PG8_STAGE(PG8_SA(1, 0), a3, voffA);
            PG8_WAIT_V(8); PG8_WAIT_L(0); PG8_BAR; PG8_MMA(1, 0, At, B0); PG8_MMA(1, 1, At, B1); PG8_BAR; PG8_SCHED;
            } else {
            PG8_LDB(B0, 0, 0); PG8_SCHED; PG8_LDA(At, 0, 0); PG8_STAGE(PG8_SA(1, 1), a1 + hstep, voffA);
            PG8_WAIT_L(8); PG8_BAR; PG8_WAIT_L(0); PG8_MMA(0, 0, At, B0); PG8_BAR; PG8_SCHED;
            PG8_LDB(B1, 0, 1); PG8_STAGE(PG8_SB(0, 0), b2, voffB);
            PG8_BAR; PG8_WAIT_L(0); PG8_MMA(0, 1, At, B1); PG8_BAR;
            PG8_LDA(At, 0, 1); PG8_STAGE(PG8_SA(0, 0), a2, voffA);
            PG8_BAR; PG8_WAIT_L(0); PG8_MMA(1, 0, At, B0); PG8_BAR; PG8_SCHED;
            PG8_STAGE(PG8_SB(0, 1), b2 + hstep, voffB);
            PG8_WAIT_V(6); PG8_BAR; PG8_MMA(1, 1, At, B1); PG8_BAR;
            PG8_LDB(B0, 1, 0); PG8_SCHED; PG8_LDA(At, 1, 0); PG8_STAGE(PG8_SA(0, 1), a2 + hstep, voffA);
            PG8_WAIT_L(8); PG8_BAR; PG8_WAIT_L(0); PG8_MMA(0, 0, At, B0); PG8_BAR; PG8_SCHED;
            PG8_LDB(B1, 1, 1); PG8_STAGE(PG8_SB(1, 0), b3, voffB);
            PG8_BAR; PG8_WAIT_L(0); PG8_MMA(0, 1, At, B1); PG8_BAR;
            PG8_LDA(At, 1, 1); PG8_STAGE(PG8_SA(1, 0), a3, voffA);
            PG8_BAR; PG8_WAIT_L(0); PG8_MMA(1, 0, At, B0); PG8_BAR; PG8_SCHED;
            PG8_STAGE(PG8_SB(1, 1), b3 + hstep, voffB);
            PG8_WAIT_V(6); PG8_BAR; PG8_MMA(1, 1, At, B1); PG8_BAR;
            }
        }
        if constexpr (ALIGN_EPI) { if (wr == 0) PG8_BAR; }
        if constexpr (!Epi::AFTER_DRAIN) { E(acc, cur, wr, wc, fr, fq); S.done(cur); }
        if (!has_next) break;
#pragma unroll
        for (int a = 0; a < 2; ++a)
#pragma unroll
            for (int b = 0; b < 2; ++b)
#pragma unroll
                for (int m = 0; m < 4; ++m)
#pragma unroll
                    for (int n = 0; n < 2; ++n) acc[a][b][m][n] = (f32x4){0.f, 0.f, 0.f, 0.f};
        cur = nxt; cA = nA; cB = nB; ++ui;
        if constexpr (ALIGN_EPI) { if (wr == 1) PG8_BAR; }
    }
    PG8_WAIT_V(0);
    if constexpr (!ALIGN_EPI) { if (wr == 0) PG8_BAR; }
    PG8_BAR;
    if constexpr (Epi::AFTER_DRAIN) { E.fused(acc, cur, wr, wc, fr, fq, lds, wid, lane); S.done(cur); }
#undef PG8_SA
#undef PG8_SB
#undef PG8_STAGE
#undef PG8_LDA
#undef PG8_LDB
#undef PG8_MMA
#undef PG8_WAIT_V
#undef PG8_WAIT_L
#undef PG8_BAR
#undef PG8_SCHED
}
}

#define LAS __attribute__((address_space(3)))
typedef unsigned short bf16_t;
typedef short bf16x8 __attribute__((ext_vector_type(8)));
typedef float f32x4 __attribute__((ext_vector_type(4)));
typedef float f32x16 __attribute__((ext_vector_type(16)));
typedef unsigned u32x2 __attribute__((ext_vector_type(2)));
typedef unsigned u32x4 __attribute__((ext_vector_type(4)));
typedef float f32x2_t __attribute__((ext_vector_type(2)));
typedef __bf16 bf16x2_t __attribute__((ext_vector_type(2)));

constexpr int BATCH = 8, SEQ = 2048, M = BATCH * SEQ, D = 1024, DEPTH = 2;
constexpr int N_IN = 2120, N_INP = 2304, DFF = 2816, NUP = 2 * DFF;
constexpr float ALPHA = 1.4142135623730951f;
constexpr float LN_EPS = 1e-5f;
constexpr float QSCALE = 0.125f * 1.4426950408889634f;
constexpr float IDX_SCALE = 0.04419417382415922f;
constexpr int NTHREADS = 512, NWAVES = 8;
constexpr int LDS_BYTES = 147456;

constexpr size_t MiB = 1u << 20;
constexpr size_t WS_W = 2 * MiB, W_LAYER = 26 * MiB;
constexpr size_t OW_IN = 0, OW_OUT = OW_IN + (size_t)N_INP * D * 2, OW_UP = OW_OUT + (size_t)D * D * 2, OW_DOWN = OW_UP + (size_t)NUP * D * 2,
                 OW_GATE = OW_DOWN + (size_t)D * DFF * 2, OW_PPROJ = OW_GATE + (size_t)D * D * 2, OW_GLU = OW_PPROJ + (size_t)D * 256 * 2, OW_END = OW_GLU + 256 * 256 * 2;
static_assert(OW_END <= W_LAYER, "weights per layer");
constexpr size_t WS_TAB = 54 * MiB, TAB_LAYER = 1 * MiB;
constexpr size_t TAB_LAM = 0, TAB_BBR = 65536, TAB_BBI = 131072, TAB_CM = 196608, TAB_SP = 262144;
constexpr size_t WS_ROPE = 56 * MiB, WS_HN = 60 * MiB, WS_PB = 92 * MiB, WS_SEL = 108 * MiB, WS_S5S = 112 * MiB, WS_Y = 114 * MiB;
constexpr size_t WS_U = 146 * MiB, WS_GRG = 154 * MiB, WS_XRG = 162 * MiB, WS_Q = 178 * MiB, WS_QI = 194 * MiB, WS_KB = 210 * MiB, WS_VT = 214 * MiB,
                 WS_KI = 218 * MiB, WS_WI = 220 * MiB, WS_RA = 222 * MiB, WS_RB = 238 * MiB, WS_ACT = 146 * MiB, WS_END = 256 * MiB;
static_assert(WS_ACT + (size_t)M * DFF * 2 <= WS_END, "act overlay");

__device__ __forceinline__ unsigned pkbf(float lo, float hi) { f32x2_t v = {lo, hi}; bf16x2_t b = __builtin_convertvector(v, bf16x2_t); return __builtin_bit_cast(unsigned, b); }
__device__ __forceinline__ float bf2f(unsigned short x) { return __uint_as_float((unsigned)x << 16); }
__device__ __forceinline__ float bflo(unsigned w) { return __uint_as_float(w << 16); }
__device__ __forceinline__ float bfhi(unsigned w) { return __uint_as_float(w & 0xffff0000u); }
__device__ __forceinline__ float sigmoidf_(float x) { return 1.0f / (1.0f + __expf(-x)); }
__device__ __forceinline__ float gelu_tanh(float x) { const float u = 0.7978845608028654f * (x + 0.044715f * x * x * x); return 0.5f * x * (1.0f + tanhf(u)); }
template <int CTRL> __device__ __forceinline__ float dppf(float v) { return __builtin_bit_cast(float, __builtin_amdgcn_update_dpp(0, __builtin_bit_cast(int, v), CTRL, 0xf, 0xf, true)); }
template <int CTRL> __device__ __forceinline__ int dppi(int v) { return __builtin_amdgcn_update_dpp(0, v, CTRL, 0xf, 0xf, true); }
__device__ __forceinline__ float rdl(float v, int l) { return __builtin_bit_cast(float, __builtin_amdgcn_readlane(__builtin_bit_cast(int, v), l)); }
__device__ __forceinline__ float wave_sum(float v) {
    v += dppf<0xB1>(v); v += dppf<0x4E>(v); v += dppf<0x141>(v); v += dppf<0x140>(v);
    return (rdl(v, 0) + rdl(v, 16)) + (rdl(v, 32) + rdl(v, 48));
}
__device__ __forceinline__ float wave_max(float v) {
    v = fmaxf(v, dppf<0xB1>(v)); v = fmaxf(v, dppf<0x4E>(v)); v = fmaxf(v, dppf<0x141>(v)); v = fmaxf(v, dppf<0x140>(v));
    return fmaxf(fmaxf(rdl(v, 0), rdl(v, 16)), fmaxf(rdl(v, 32), rdl(v, 48)));
}
__device__ __forceinline__ float wave_min(float v) {
    v = fminf(v, dppf<0xB1>(v)); v = fminf(v, dppf<0x4E>(v)); v = fminf(v, dppf<0x141>(v)); v = fminf(v, dppf<0x140>(v));
    return fminf(fminf(rdl(v, 0), rdl(v, 16)), fminf(rdl(v, 32), rdl(v, 48)));
}
__device__ __forceinline__ int wave_sum_i(int v) {
    v += dppi<0xB1>(v); v += dppi<0x4E>(v); v += dppi<0x141>(v); v += dppi<0x140>(v);
    return (__builtin_amdgcn_readlane(v, 0) + __builtin_amdgcn_readlane(v, 16)) + (__builtin_amdgcn_readlane(v, 32) + __builtin_amdgcn_readlane(v, 48));
}
__device__ __forceinline__ float xhalf_max(float v) { auto rr = __builtin_amdgcn_permlane32_swap(__float_as_uint(v), __float_as_uint(v), false, false); return fmaxf(__uint_as_float(rr[0]), __uint_as_float(rr[1])); }
__device__ __forceinline__ float xhalf_sum(float v) { auto rr = __builtin_amdgcn_permlane32_swap(__float_as_uint(v), __float_as_uint(v), false, false); return __uint_as_float(rr[0]) + __uint_as_float(rr[1]); }

using pg8::Unit;
struct EpiProj {
    static constexpr bool PERM = false, AFTER_DRAIN = false;
    bf16_t *U, *GRG, *Q, *KB, *VT, *QI, *KI; float *XRG, *WI; const float* ROPE;
    __device__ __forceinline__ void rope_half(const f32x4 (&acc)[2][2][4][2], int bj, const Unit& u, int wr, int wc, int fr, int fq, bf16_t* base, int ld, float sc) const {
        const int d0 = 16 * (wc & 1) + 4 * fq, hdl = wc >> 1;
#pragma unroll
        for (int ai = 0; ai < 2; ++ai)
#pragma unroll
            for (int m = 0; m < 4; ++m) {
                const int row = u.pm * 256 + ai * 128 + wr * 64 + m * 16 + fr;
                const f32x4 cs = *(const f32x4*)(ROPE + (size_t)row * 64 + d0) * sc, sn = *(const f32x4*)(ROPE + (size_t)row * 64 + 32 + d0) * sc;
                const f32x4 a0 = acc[ai][bj][m][0], a1 = acc[ai][bj][m][1];
                const f32x4 o1 = a0 * cs - a1 * sn, o2 = a1 * cs + a0 * sn;
                bf16_t* dst = base + (size_t)row * ld + 64 * hdl + d0;
                *(u32x2*)dst = (u32x2){pkbf(o1[0], o1[1]), pkbf(o1[2], o1[3])};
                *(u32x2*)(dst + 32) = (u32x2){pkbf(o2[0], o2[1]), pkbf(o2[2], o2[3])};
                asm volatile("" ::: "memory");
            }
    }
    __device__ __forceinline__ void operator()(const f32x4 (&acc)[2][2][4][2], const Unit& u, int wr, int wc, int fr, int fq) const {
        asm volatile("" : "+v"(fr), "+v"(fq));
        const int pn = u.pn;
        if (pn == 0 || pn == 2) {
            bf16_t* O = (pn == 0 ? U : GRG);
#pragma unroll
            for (int ai = 0; ai < 2; ++ai)
#pragma unroll
                for (int m = 0; m < 4; ++m) { bf16_t* rp = O + (size_t)(u.pm * 256 + ai * 128 + wr * 64 + m * 16 + fr) * 256 + wc * 32 + 4 * fq;
#pragma unroll
                    for (int bj = 0; bj < 2; ++bj)
#pragma unroll
                        for (int n = 0; n < 2; ++n) { const f32x4 v = acc[ai][bj][m][n]; *(u32x2*)(rp + bj * 128 + n * 16) = (u32x2){pkbf(v[0], v[1]), pkbf(v[2], v[3])}; }
                    asm volatile("" ::: "memory"); }
        } else if (pn == 1) {
#pragma unroll
            for (int ai = 0; ai < 2; ++ai)
#pragma unroll
                for (int m = 0; m < 4; ++m) { float* rp = XRG + (size_t)(u.pm * 256 + ai * 128 + wr * 64 + m * 16 + fr) * 256 + wc * 32 + 4 * fq;
#pragma unroll
                    for (int bj = 0; bj < 2; ++bj)
#pragma unroll
                        for (int n = 0; n < 2; ++n) *(f32x4*)(rp + bj * 128 + n * 16) = acc[ai][bj][m][n];
                    asm volatile("" ::: "memory"); }
        } else if (pn == 3 || pn == 4) {
            rope_half(acc, 0, u, wr, wc, fr, fq, Q + 256 * (pn - 3), 512, QSCALE); rope_half(acc, 1, u, wr, wc, fr, fq, Q + 256 * (pn - 3) + 128, 512, QSCALE);
        } else if (pn == 6 || pn == 7) {
            rope_half(acc, 0, u, wr, wc, fr, fq, QI + 256 * (pn - 6), 512, 1.0f); rope_half(acc, 1, u, wr, wc, fr, fq, QI + 256 * (pn - 6) + 128, 512, 1.0f);
        } else if (pn == 5) {
            rope_half(acc, 0, u, wr, wc, fr, fq, KB, 128, 1.0f);
            const int g = wc >> 1;
#pragma unroll
            for (int ai = 0; ai < 2; ++ai)
#pragma unroll
                for (int m = 0; m < 4; ++m) { const int row = u.pm * 256 + ai * 128 + wr * 64 + m * 16 + fr, b = row >> 11, t = row & 2047;
#pragma unroll
                    for (int n = 0; n < 2; ++n) { const f32x4 v = acc[ai][1][m][n];
#pragma unroll
                        for (int i = 0; i < 4; ++i) { const int d = 32 * (wc & 1) + 16 * n + 4 * fq + i; VT[((size_t)(b * 2 + g) * 64 + d) * 2048 + t] = (bf16_t)(pkbf(v[i], 0.f) & 0xffffu); } }
                    asm volatile("" ::: "memory"); }
        } else {
            if (wc < 2) rope_half(acc, 0, u, wr, wc, fr, fq, KI, 64, 1.0f);
            if (wc == 0 && fq < 2) {
#pragma unroll
                for (int ai = 0; ai < 2; ++ai)
#pragma unroll
                    for (int m = 0; m < 4; ++m) *(f32x4*)(WI + (size_t)(u.pm * 256 + ai * 128 + wr * 64 + m * 16 + fr) * 8 + 4 * fq) = acc[ai][1][m][0];
            }
        }
    }
};
struct EpiResid {
    static constexpr bool PERM = false, AFTER_DRAIN = false;
    float* H;
    __device__ __forceinline__ void operator()(const f32x4 (&acc)[2][2][4][2], const Unit& u, int wr, int wc, int fr, int fq) const {
        asm volatile("" : "+v"(fr), "+v"(fq));
#pragma unroll
        for (int ai = 0; ai < 2; ++ai)
#pragma unroll
            for (int m = 0; m < 4; ++m) { float* rp = H + (size_t)(u.pm * 256 + ai * 128 + wr * 64 + m * 16 + fr) * D + u.pn * 256 + wc * 32 + 4 * fq;
#pragma unroll
                for (int bj = 0; bj < 2; ++bj)
#pragma unroll
                    for (int n = 0; n < 2; ++n) { f32x4* p = (f32x4*)(rp + bj * 128 + n * 16); *p = *p * ALPHA + acc[ai][bj][m][n]; }
                asm volatile("" ::: "memory"); }
    }
};
struct EpiStoreBf16 {
    static constexpr bool PERM = false, AFTER_DRAIN = false;
    bf16_t* O; int ldc;
    __device__ __forceinline__ void operator()(const f32x4 (&acc)[2][2][4][2], const Unit& u, int wr, int wc, int fr, int fq) const {
        asm volatile("" : "+v"(fr), "+v"(fq));
#pragma unroll
        for (int ai = 0; ai < 2; ++ai)
#pragma unroll
            for (int m = 0; m < 4; ++m) { bf16_t* rp = O + (size_t)(u.pm * 256 + ai * 128 + wr * 64 + m * 16 + fr) * ldc + u.pn * 256 + wc * 32 + 4 * fq;
#pragma unroll
                for (int bj = 0; bj < 2; ++bj)
#pragma unroll
                    for (int n = 0; n < 2; ++n) { const f32x4 v = acc[ai][bj][m][n]; *(u32x2*)(rp + bj * 128 + n * 16) = (u32x2){pkbf(v[0], v[1]), pkbf(v[2], v[3])}; } }
    }
};
struct EpiSwiglu {
    static constexpr bool PERM = false, AFTER_DRAIN = false;
    bf16_t* ACT;
    __device__ __forceinline__ void operator()(const f32x4 (&acc)[2][2][4][2], const Unit& u, int wr, int wc, int fr, int fq) const {
        asm volatile("" : "+v"(fr), "+v"(fq));
#pragma unroll
        for (int ai = 0; ai < 2; ++ai)
#pragma unroll
            for (int m = 0; m < 4; ++m) { bf16_t* rp = ACT + (size_t)(u.pm * 256 + ai * 128 + wr * 64 + m * 16 + fr) * DFF + u.pn * 128 + wc * 32 + 4 * fq;
#pragma unroll
                for (int n = 0; n < 2; ++n) { const f32x4 g = acc[ai][0][m][n], uu = acc[ai][1][m][n]; f32x4 o;
#pragma unroll
                    for (int i = 0; i < 4; ++i) o[i] = g[i] * sigmoidf_(g[i]) * uu[i];
                    *(u32x2*)(rp + n * 16) = (u32x2){pkbf(o[0], o[1]), pkbf(o[2], o[3])}; } }
    }
};
struct EpiPle {
    static constexpr bool PERM = false, AFTER_DRAIN = false;
    bf16_t* PP;
    __device__ __forceinline__ void operator()(const f32x4 (&acc)[2][2][4][2], const Unit& u, int wr, int wc, int fr, int fq) const {
        asm volatile("" : "+v"(fr), "+v"(fq));
#pragma unroll
        for (int ai = 0; ai < 2; ++ai)
#pragma unroll
            for (int m = 0; m < 4; ++m) { bf16_t* rp = PP + (size_t)(u.pm * 256 + ai * 128 + wr * 64 + m * 16 + fr) * D + u.pn * 256 + wc * 32 + 4 * fq;
#pragma unroll
                for (int bj = 0; bj < 2; ++bj)
#pragma unroll
                    for (int n = 0; n < 2; ++n) { const f32x4 v = acc[ai][bj][m][n]; u32x2* p = (u32x2*)(rp + bj * 128 + n * 16); const u32x2 w = *p;
                        *p = (u32x2){pkbf(sigmoidf_(v[0]) * bflo(w[0]), sigmoidf_(v[1]) * bfhi(w[0])), pkbf(sigmoidf_(v[2]) * bflo(w[1]), sigmoidf_(v[3]) * bfhi(w[1]))}; }
                asm volatile("" ::: "memory"); }
    }
};
struct EpiDown {
    static constexpr bool PERM = false, AFTER_DRAIN = false;
    float* H; const bf16_t* PP;
    __device__ __forceinline__ void operator()(const f32x4 (&acc)[2][2][4][2], const Unit& u, int wr, int wc, int fr, int fq) const {
        asm volatile("" : "+v"(fr), "+v"(fq));
#pragma unroll
        for (int ai = 0; ai < 2; ++ai)
#pragma unroll
            for (int m = 0; m < 4; ++m) { const size_t off = (size_t)(u.pm * 256 + ai * 128 + wr * 64 + m * 16 + fr) * D + u.pn * 256 + wc * 32 + 4 * fq;
#pragma unroll
                for (int bj = 0; bj < 2; ++bj)
#pragma unroll
                    for (int n = 0; n < 2; ++n) { f32x4* p = (f32x4*)(H + off + bj * 128 + n * 16); const u32x2 w = *(const u32x2*)(PP + off + bj * 128 + n * 16);
                        const f32x4 pl = {bflo(w[0]), bfhi(w[0]), bflo(w[1]), bfhi(w[1])}; *p = *p * ALPHA + acc[ai][bj][m][n] + pl; }
                asm volatile("" ::: "memory"); }
    }
};

struct Args { const void* in[32]; float* out; unsigned char* ws; int ph_lo, ph_hi; };
typedef const __attribute__((address_space(4))) Args* KArgs;
struct Ctx {
    KArgs a; unsigned char* ws; LAS unsigned char* lds; unsigned char* ldsg;
    int tid, lane, wave, bid, G;
};
#define INF_(i, T) ((const T*)c.a->in[i])

__device__ __forceinline__ int colmap(int kind, int pos) {
    if (kind == 0) return pos;
    const int tile = pos >> 8, p = pos & 255, bj = p >> 7, ph = p & 127;
    if (kind == 2) return (bj ? DFF : 0) + 128 * tile + ph;
    const int wc = ph >> 5, n = (ph >> 4) & 1, fq = (ph >> 2) & 3, i = ph & 3;
    const int rc = 64 * (wc >> 1) + 32 * n + 16 * (wc & 1) + 4 * fq + i;
    if (tile <= 2) return pos;
    if (tile <= 4) return 768 + 256 * (tile - 3) + 128 * bj + rc;
    if (tile == 5) return bj == 0 ? 1280 + rc : 1408 + ph;
    if (tile <= 7) return 1536 + 256 * (tile - 6) + 128 * bj + rc;
    return bj == 0 ? (rc < 64 ? 2048 + rc : -1) : (ph < 8 ? 2112 + ph : -1);
}
__device__ __forceinline__ void transpose_item(const float* W, int K, int N, bf16_t* WT, int kind, LAS float* scr, int item, int nblk, int lane) {
    const int kb = item / nblk, nb = item % nblk, k0 = 64 * kb, n0 = 32 * nb;
    const int col = colmap(kind, n0 + (lane & 31));
#pragma unroll 8
    for (int i = 0; i < 32; ++i) { const int kk = 2 * i + (lane >> 5); scr[kk * 33 + (lane & 31)] = col >= 0 ? W[(size_t)(k0 + kk) * N + col] : 0.f; }
    asm volatile("s_waitcnt lgkmcnt(0)" ::: "memory");
    const int cc = lane & 7;
#pragma unroll
    for (int j = 0; j < 4; ++j) { const int n = (lane >> 3) + 8 * j; const LAS float* s = scr + (8 * cc) * 33 + n;
        u32x4 o; o.x = pkbf(s[0 * 33], s[1 * 33]); o.y = pkbf(s[2 * 33], s[3 * 33]); o.z = pkbf(s[4 * 33], s[5 * 33]); o.w = pkbf(s[6 * 33], s[7 * 33]);
        *(u32x4*)(WT + (size_t)(n0 + n) * K + k0 + 8 * cc) = o; }
    asm volatile("s_waitcnt lgkmcnt(0)" ::: "memory");
}
__device__ __forceinline__ void ln_row(const float* xrow, const float* g, const float* b, float* orow, bf16_t* brow, int lane) {
    const f32x4* xr = (const f32x4*)xrow + lane;
    f32x4 v[4]; float s = 0.f;
#pragma unroll
    for (int j = 0; j < 4; ++j) { v[j] = xr[64 * j]; s += (v[j][0] + v[j][1]) + (v[j][2] + v[j][3]); }
    const float mean = wave_sum(s) * (1.f / D); float s2 = 0.f;
#pragma unroll
    for (int j = 0; j < 4; ++j) { v[j] = v[j] - mean; s2 += (v[j][0] * v[j][0] + v[j][1] * v[j][1]) + (v[j][2] * v[j][2] + v[j][3] * v[j][3]); }
    const float rstd = 1.f / sqrtf(wave_sum(s2) * (1.f / D) + LN_EPS);
#pragma unroll
    for (int j = 0; j < 4; ++j) { const f32x4 gg = ((const f32x4*)g)[lane + 64 * j], bb = ((const f32x4*)b)[lane + 64 * j]; const f32x4 o = v[j] * rstd * gg + bb;
        ((f32x4*)orow)[lane + 64 * j] = o; ((u32x2*)brow)[lane + 64 * j] = (u32x2){pkbf(o[0], o[1]), pkbf(o[2], o[3])}; }
}
__device__ __forceinline__ void ln_pass(const Ctx& c, float* H, const float* g, const float* b, bf16_t* HN) {
    const int gw = c.bid * NWAVES + c.wave, NGW = c.G * NWAVES;
    for (int m = gw; m < M; m += NGW) ln_row(H + (size_t)m * D, g, b, H + (size_t)m * D, HN + (size_t)m * D, c.lane);
}

__device__ __forceinline__ void prologue(const Ctx& c) {
    const int gw = c.bid * NWAVES + c.wave, NGW = c.G * NWAVES;
    const int gt = c.bid * NTHREADS + c.tid, NGT = c.G * NTHREADS;
    {
        LAS float* scr = (LAS float*)(c.lds + c.wave * 16384);
        constexpr int I_IN = 16 * (N_INP / 32), I_OUT = 16 * 32, I_UP = 16 * (NUP / 32), I_DOWN = (DFF / 64) * 32, I_GATE = 16 * 32, I_PP = 4 * 32, I_GLU = 4 * 8;
        constexpr int I_LAYER = I_IN + I_OUT + I_UP + I_DOWN + I_GATE + I_PP + I_GLU;
        for (int it = gw; it < DEPTH * I_LAYER; it += NGW) {
            const int L = it / I_LAYER; int r = it % I_LAYER; unsigned char* wl = c.ws + WS_W + (size_t)L * W_LAYER;
            if (r < I_IN) { transpose_item(INF_(5, float) + (size_t)L * D * N_IN, D, N_IN, (bf16_t*)(wl + OW_IN), 1, scr, r, N_INP / 32, c.lane); continue; } r -= I_IN;
            if (r < I_OUT) { transpose_item(INF_(23, float) + (size_t)L * D * D, D, D, (bf16_t*)(wl + OW_OUT), 0, scr, r, 32, c.lane); continue; } r -= I_OUT;
            if (r < I_UP) { transpose_item(INF_(26, float) + (size_t)L * D * NUP, D, NUP, (bf16_t*)(wl + OW_UP), 2, scr, r, NUP / 32, c.lane); continue; } r -= I_UP;
            if (r < I_DOWN) { transpose_item(INF_(27, float) + (size_t)L * DFF * D, DFF, D, (bf16_t*)(wl + OW_DOWN), 0, scr, r, 32, c.lane); continue; } r -= I_DOWN;
            if (r < I_GATE) { transpose_item(INF_(28, float) + (size_t)L * D * D, D, D, (bf16_t*)(wl + OW_GATE), 0, scr, r, 32, c.lane); continue; } r -= I_GATE;
            if (r < I_PP) { transpose_item(INF_(29, float) + (size_t)L * 256 * D, 256, D, (bf16_t*)(wl + OW_PPROJ), 0, scr, r, 32, c.lane); continue; } r -= I_PP;
            transpose_item(INF_(14, float) + (size_t)L * 256 * 256, 256, 256, (bf16_t*)(wl + OW_GLU), 0, scr, r, 8, c.lane);
        }
    }
    {
        float* ROPE = (float*)(c.ws + WS_ROPE); const int* pos = INF_(2, int);
        for (int e = gt; e < M * 32; e += NGT) { const int m = e >> 5, i = e & 31;
            const float inv = (float)pow(10000.0, -(double)i / 32.0); const float ang = (float)pos[m] * inv;
            ROPE[(size_t)m * 64 + i] = (float)cos((double)ang); ROPE[(size_t)m * 64 + 32 + i] = (float)sin((double)ang); }
    }
    {
        const float* x = INF_(0, float); float* H = c.a->out; bf16_t* HN = (bf16_t*)(c.ws + WS_HN);
        for (int m = gw; m < M; m += NGW) ln_row(x + (size_t)m * D, INF_(3, float), INF_(4, float), H + (size_t)m * D, HN + (size_t)m * D, c.lane);
    }
    for (int e = gt; e < DEPTH * 1024; e += NGT) {
        const int L = e >> 10, gp = e & 1023, g = gp >> 6, p = gp & 63; unsigned char* tb = c.ws + WS_TAB + (size_t)L * TAB_LAYER;
        const double lr = INF_(6, float)[L * 1024 + gp], li = INF_(7, float)[L * 1024 + gp], st = exp((double)INF_(8, float)[L * 16 + g]);
        const double mag = exp(lr * st), ar = mag * cos(li * st), ai = mag * sin(li * st);
        const double mag64 = exp(64.0 * lr * st), ar64 = mag64 * cos(64.0 * li * st), ai64 = mag64 * sin(64.0 * li * st);
        ((f32x4*)(tb + TAB_LAM))[gp] = (f32x4){(float)ar, (float)ai, (float)ar64, (float)ai64};
        const double den = lr * lr + li * li, nr = ar - 1.0, ni = ai, cr = (nr * lr + ni * li) / den, ci = (ni * lr - nr * li) / den;
        const float* bre = INF_(9, float) + ((size_t)L * 1024 + gp) * 16; const float* bim = INF_(10, float) + ((size_t)L * 1024 + gp) * 16;
        float* BBR = (float*)(tb + TAB_BBR); float* BBI = (float*)(tb + TAB_BBI);
        for (int q = 0; q < 16; ++q) { const double br = bre[q], bi = bim[q]; BBR[(g * 16 + q) * 64 + p] = (float)(cr * br - ci * bi); BBI[(g * 16 + q) * 64 + p] = (float)(cr * bi + ci * br); }
        const float* cre = INF_(11, float) + (size_t)L * 16384 + g * 1024; const float* cim = INF_(12, float) + (size_t)L * 16384 + g * 1024;
        unsigned* CM = (unsigned*)(tb + TAB_CM);
        for (int co = 0; co < 16; ++co) CM[(g * 16 + co) * 64 + p] = pkbf(cre[co * 64 + p], -cim[co * 64 + p]);
    }
    for (int e = gt; e < DEPTH * 256; e += NGT) { const int L = e >> 8, j = e & 255; const float lam = INF_(22, float)[e];
        ((float*)(c.ws + WS_TAB + (size_t)L * TAB_LAYER + TAB_SP))[j] = (float)log1p(exp(-(double)lam)); }
    {
        const f32x4* p4 = (const f32x4*)INF_(1, float); u32x4* pb = (u32x4*)(c.ws + WS_PB);
        for (int e = gt; e < DEPTH * M * 256 / 8; e += NGT) { const f32x4 a = p4[2 * e], b = p4[2 * e + 1]; pb[e] = (u32x4){pkbf(a[0], a[1]), pkbf(a[2], a[3]), pkbf(b[0], b[1]), pkbf(b[2], b[3])}; }
    }
}

struct S5State { float bbr[2][16], bbi[2][16], ar[2], ai[2], xr[2], xi[2]; };
__device__ __forceinline__ void s5_load_params(const Ctx& c, int L, S5State& S) {
    const unsigned char* tb = c.ws + WS_TAB + (size_t)L * TAB_LAYER;
    unsigned lo_ = (unsigned)c.lane * 4u; asm volatile("" : "+v"(lo_));
#pragma unroll
    for (int s = 0; s < 2; ++s) { const int g = 2 * c.wave + s; const f32x4 lm = ((const f32x4*)(tb + TAB_LAM))[g * 64 + c.lane]; S.ar[s] = lm[0]; S.ai[s] = lm[1];
        const unsigned char* pr = tb + TAB_BBR + (size_t)g * 4096 + lo_; const unsigned char* pi = tb + TAB_BBI + (size_t)g * 4096 + lo_;
#pragma unroll
        for (int q = 0; q < 16; ++q) { S.bbr[s][q] = *(const float*)(pr + q * 256); S.bbi[s][q] = *(const float*)(pi + q * 256); } }
}
__device__ __forceinline__ void s5_load_u(const Ctx& c, int chunk) {
    const u32x4* src = (const u32x4*)(c.ws + WS_U + (size_t)chunk * 64 * 512);
#pragma unroll
    for (int i = 0; i < 4; ++i) *(LAS u32x4*)(c.lds + (c.tid + i * 512) * 16) = src[c.tid + i * 512];
}
__device__ __forceinline__ void s5_step(const Ctx& c, S5State& S, int t) {
#pragma unroll
    for (int s = 0; s < 2; ++s) { const int g = 2 * c.wave + s;
        const u32x4 ua = *(const LAS u32x4*)(c.lds + t * 512 + g * 32), ub = *(const LAS u32x4*)(c.lds + t * 512 + g * 32 + 16);
        float uu[16];
#pragma unroll
        for (int q = 0; q < 4; ++q) { uu[2 * q] = bflo(ua[q]); uu[2 * q + 1] = bfhi(ua[q]); uu[8 + 2 * q] = bflo(ub[q]); uu[8 + 2 * q + 1] = bfhi(ub[q]); }
        float br = 0.f, bi = 0.f;
#pragma unroll
        for (int q = 0; q < 16; ++q) { br = fmaf(S.bbr[s][q], uu[q], br); bi = fmaf(S.bbi[s][q], uu[q], bi); }
        const float nr = S.ar[s] * S.xr[s] - S.ai[s] * S.xi[s] + br, ni = S.ar[s] * S.xi[s] + S.ai[s] * S.xr[s] + bi;
        S.xr[s] = nr; S.xi[s] = ni; }
}
__device__ __forceinline__ void s5_pass1_unit(const Ctx& c, int L, int chunk) {
    S5State S; s5_load_params(c, L, S); s5_load_u(c, chunk);
    S.xr[0] = S.xi[0] = S.xr[1] = S.xi[1] = 0.f;
    __syncthreads();
#pragma unroll 1
    for (int t = 0; t < 64; ++t) s5_step(c, S, t);
    f32x2_t* out = (f32x2_t*)(c.ws + WS_S5S) + (size_t)chunk * 1024;
#pragma unroll
    for (int s = 0; s < 2; ++s) out[(2 * c.wave + s) * 64 + c.lane] = (f32x2_t){S.xr[s], S.xi[s]};
    __syncthreads();
}
constexpr int S5_YP = 32768, S5_YP_STRIDE = 264, S5_XS = S5_YP + 64 * S5_YP_STRIDE * 2;
static_assert(S5_XS + 8 * 8192 <= LDS_BYTES, "s5 lds");
__device__ __forceinline__ void s5_pass2_unit(const Ctx& c, int L, int chunk) {
    const unsigned char* tb = c.ws + WS_TAB + (size_t)L * TAB_LAYER;
    S5State S; s5_load_params(c, L, S); s5_load_u(c, chunk);
    int lane = c.lane; asm volatile("" : "+v"(lane));
    const int w = c.wave, fr = lane & 15, fq = lane >> 4;
    {
        const int cs = chunk & 31; const f32x2_t* sp = (const f32x2_t*)(c.ws + WS_S5S) + (size_t)(chunk - cs) * 1024;
#pragma unroll
        for (int s = 0; s < 2; ++s) { const int gp = (2 * w + s) * 64 + lane; const f32x4 lm = ((const f32x4*)(tb + TAB_LAM))[gp]; float xr = 0.f, xi = 0.f;
            for (int k = 0; k < cs; ++k) { const f32x2_t sv = sp[(size_t)k * 1024 + gp]; const float nr = lm[2] * xr - lm[3] * xi + sv[0], ni = lm[2] * xi + lm[3] * xr + sv[1]; xr = nr; xi = ni; }
            S.xr[s] = xr; S.xi[s] = xi; }
    }
    const unsigned char* cmp = tb + TAB_CM + ((size_t)((2 * w) * 16 + fr) * 128 + 8 * fq) * 2;
    const float* dsk = INF_(13, float) + L * 256;
    float dk[2]; dk[0] = dsk[(2 * w) * 16 + fr]; dk[1] = dsk[(2 * w + 1) * 16 + fr];
    __syncthreads();
    LAS unsigned char* xs = c.lds + S5_XS + w * 8192;
#pragma unroll 1
    for (int sb = 0; sb < 4; ++sb) {
#pragma unroll 1
        for (int tt = 0; tt < 16; ++tt) {
            s5_step(c, S, sb * 16 + tt);
#pragma unroll
            for (int s = 0; s < 2; ++s) *(LAS unsigned*)(xs + (tt * 2 + s) * 256 + lane * 4) = pkbf(S.xr[s], S.xi[s]);
        }
#pragma unroll
        for (int s = 0; s < 2; ++s) {
            f32x4 acc = {0.f, 0.f, 0.f, 0.f};
#pragma unroll
            for (int ks = 0; ks < 4; ++ks) { const bf16x8 af = *(const LAS bf16x8*)(xs + (fr * 2 + s) * 256 + (32 * ks + 8 * fq) * 2);
                const bf16x8 cmf = *(const bf16x8*)(cmp + s * 4096 + ks * 64);
                acc = __builtin_amdgcn_mfma_f32_16x16x32_bf16(af, cmf, acc, 0, 0, 0); }
            const int g = 2 * w + s;
#pragma unroll
            for (int i = 0; i < 4; ++i) { const int t = sb * 16 + 4 * fq + i; const float uv = bf2f(*(const LAS unsigned short*)(c.lds + t * 512 + (g * 16 + fr) * 2));
                const float y = gelu_tanh(acc[i] + dk[s] * uv);
                *(LAS unsigned short*)(c.lds + S5_YP + (t * S5_YP_STRIDE + g * 16 + fr) * 2) = (unsigned short)(pkbf(y, 0.f) & 0xffffu); }
        }
    }
    __syncthreads();
    {
        const bf16_t* GT = (const bf16_t*)(c.ws + WS_W + (size_t)L * W_LAYER + OW_GLU);
        f32x4 z[4][2];
#pragma unroll
        for (int tb_ = 0; tb_ < 4; ++tb_) { z[tb_][0] = (f32x4){0.f, 0.f, 0.f, 0.f}; z[tb_][1] = (f32x4){0.f, 0.f, 0.f, 0.f}; }
#pragma unroll 1
        for (int ks = 0; ks < 8; ++ks) {
            bf16x8 bfr[2];
#pragma unroll
            for (int nt = 0; nt < 2; ++nt) bfr[nt] = *(const bf16x8*)(GT + (size_t)(32 * w + 16 * nt + fr) * 256 + 32 * ks + 8 * fq);
#pragma unroll
            for (int tb_ = 0; tb_ < 4; ++tb_) { const bf16x8 af = *(const LAS bf16x8*)(c.lds + S5_YP + ((16 * tb_ + fr) * S5_YP_STRIDE + 32 * ks + 8 * fq) * 2);
#pragma unroll
                for (int nt = 0; nt < 2; ++nt) z[tb_][nt] = __builtin_amdgcn_mfma_f32_16x16x32_bf16(af, bfr[nt], z[tb_][nt], 0, 0, 0); }
        }
        const float* bg = INF_(15, float) + L * 256; bf16_t* Y = (bf16_t*)(c.ws + WS_Y);
#pragma unroll
        for (int nt = 0; nt < 2; ++nt) { const int n = 32 * w + 16 * nt + fr; const float bgn = bg[n];
#pragma unroll
            for (int tb_ = 0; tb_ < 4; ++tb_)
#pragma unroll
                for (int i = 0; i < 4; ++i) { const int t = 16 * tb_ + 4 * fq + i; const float yp = bf2f(*(const LAS unsigned short*)(c.lds + S5_YP + (t * S5_YP_STRIDE + n) * 2));
                    Y[(size_t)(chunk * 64 + t) * D + n] = (bf16_t)(pkbf(yp * sigmoidf_(z[tb_][nt][i] + bgn), 0.f) & 0xffffu); } }
    }
    __syncthreads();
}

__device__ __forceinline__ void rg_pass1_unit(const Ctx& c, int L, int u) {
    int tid_ = c.tid; asm volatile("" : "+v"(tid_));
    const int j = tid_ & 255, half = tid_ >> 8, m0 = u * 64, tl0 = half * 32;
    const float* X = (const float*)(c.ws + WS_XRG);
    const float* cw = INF_(16, float) + L * 1024; const float cb = INF_(17, float)[L * 256 + j];
    const float w0 = cw[j], w1 = cw[256 + j], w2 = cw[512 + j], w3 = cw[768 + j];
    LAS float* xc = (LAS float*)c.lds;
    {
        const int mm = m0 + tl0; const bool seq_start = ((mm & 2047) == 0);
        float x0 = seq_start ? 0.f : X[(size_t)(mm - 3) * 256 + j], x1 = seq_start ? 0.f : X[(size_t)(mm - 2) * 256 + j], x2 = seq_start ? 0.f : X[(size_t)(mm - 1) * 256 + j];
        for (int t = 0; t < 32; ++t) { const float x3 = X[(size_t)(mm + t) * 256 + j]; xc[(tl0 + t) * 256 + j] = cb + w0 * x0 + w1 * x1 + w2 * x2 + w3 * x3; x0 = x1; x1 = x2; x2 = x3; }
    }
    const int hb = j >> 5, jj = j & 31;
    float wa[32], wx[32];
    { const float* WA = INF_(18, float) + (size_t)L * 8192 + hb * 1024; const float* WX = INF_(20, float) + (size_t)L * 8192 + hb * 1024;
#pragma unroll
      for (int i = 0; i < 32; ++i) { wa[i] = WA[i * 32 + jj]; wx[i] = WX[i * 32 + jj]; } }
    const float ba = INF_(19, float)[L * 256 + j], bx = INF_(21, float)[L * 256 + j];
    const float sp = ((const float*)(c.ws + WS_TAB + (size_t)L * TAB_LAYER + TAB_SP))[j];
    float* RA = (float*)(c.ws + WS_RA); float* RB = (float*)(c.ws + WS_RB);
    __syncthreads();
    for (int t = 0; t < 32; ++t) { const int tl = tl0 + t; float ra = ba, rx = bx;
#pragma unroll
        for (int i4 = 0; i4 < 8; ++i4) { const f32x4 xv = *(const LAS f32x4*)(xc + tl * 256 + hb * 32 + 4 * i4);
#pragma unroll
            for (int q = 0; q < 4; ++q) { ra = fmaf(xv[q], wa[4 * i4 + q], ra); rx = fmaf(xv[q], wx[4 * i4 + q], rx); } }
        const float r = sigmoidf_(ra), ig = sigmoidf_(rx), xcv = xc[tl * 256 + j];
        const float log_a = -8.0f * r * sp, a = expf(log_a), mult = sqrtf(-expm1f(2.0f * log_a));
        RA[(size_t)(m0 + tl) * 256 + j] = a; RB[(size_t)(m0 + tl) * 256 + j] = mult * (ig * xcv); }
    __syncthreads();
}
__device__ __forceinline__ void rg_scan_unit(const Ctx& c, int u) {
    int tid_ = c.tid; asm volatile("" : "+v"(tid_));
    const int b = u >> 3, hb = u & 7, jj = tid_ & 31, seg = tid_ >> 5, j = hb * 32 + jj;
    const float* RA = (const float*)(c.ws + WS_RA) + (size_t)(b * 2048 + seg * 128) * 256 + j; const float* RB = (const float*)(c.ws + WS_RB) + (size_t)(b * 2048 + seg * 128) * 256 + j;
    float A = 1.f, Hh = 0.f;
#pragma unroll 8
    for (int t = 0; t < 128; ++t) { const float a = RA[(size_t)t * 256], bv = RB[(size_t)t * 256]; Hh = fmaf(a, Hh, bv); A *= a; }
    LAS float* ex = (LAS float*)c.lds;
    ex[(seg * 32 + jj) * 2] = A; ex[(seg * 32 + jj) * 2 + 1] = Hh;
    __syncthreads();
    float h = 0.f;
    for (int s = 0; s < seg; ++s) h = fmaf(ex[(s * 32 + jj) * 2], h, ex[(s * 32 + jj) * 2 + 1]);
    const bf16_t* G = (const bf16_t*)(c.ws + WS_GRG) + (size_t)(b * 2048 + seg * 128) * 256 + j; bf16_t* Y = (bf16_t*)(c.ws + WS_Y) + (size_t)(b * 2048 + seg * 128) * D + 256 + j;
#pragma unroll 8
    for (int t = 0; t < 128; ++t) { const float a = RA[(size_t)t * 256], bv = RB[(size_t)t * 256]; h = fmaf(a, h, bv);
        Y[(size_t)t * D] = (bf16_t)(pkbf(h * gelu_tanh(bf2f(G[(size_t)t * 256])), 0.f) & 0xffffu); }
    __syncthreads();
}

constexpr int IDX_STRIDE = 2064;
static_assert(16 * IDX_STRIDE * 4 <= LDS_BYTES, "indexer lds");
template <int NR>
__device__ __forceinline__ void select_row(const LAS float* row, int nk, int lane, unsigned* selrow) {
    float v[NR];
#pragma unroll
    for (int r = 0; r < NR; ++r) { const int idx = 64 * r + lane; v[r] = idx < nk ? row[idx] : -INFINITY; }
    float mx = -INFINITY, mn = INFINITY;
#pragma unroll
    for (int r = 0; r < NR; ++r) { mx = fmaxf(mx, v[r]); mn = fminf(mn, v[r] == -INFINITY ? INFINITY : v[r]); }
    mx = wave_max(mx); mn = wave_min(mn);
    float lo = mn, hi = mx, thr = 0.f; bool tie = false; int cgt = 0;
    {
        int ch = 0;
#pragma unroll
        for (int r = 0; r < NR; ++r) ch += (v[r] >= hi) ? 1 : 0;
        ch = wave_sum_i(ch);
        if (ch >= 256) { tie = true; lo = hi; cgt = 0; }
        else {
            cgt = ch;
            for (;;) {
                const float mid = lo + 0.5f * (hi - lo);
                if (!(mid > lo) || !(mid < hi)) { tie = true; break; }
                int cm = 0;
#pragma unroll
                for (int r = 0; r < NR; ++r) cm += (v[r] >= mid) ? 1 : 0;
                cm = wave_sum_i(cm);
                if (cm == 256) { thr = mid; break; }
                if (cm > 256) lo = mid; else { hi = mid; cgt = cm; }
            }
        }
    }
    unsigned long long mine = 0ull;
    if (!tie) {
#pragma unroll
        for (int r = 0; r < NR; ++r) { const unsigned long long mk = __ballot(v[r] >= thr); if (lane == r) mine = mk; }
    } else {
        int need = 256 - cgt, base = 0;
#pragma unroll
        for (int r = 0; r < NR; ++r) { const unsigned long long tm = __ballot(v[r] == lo); const int rank = base + __builtin_popcountll(tm & ((1ull << lane) - 1ull));
            const unsigned long long mk = __ballot(v[r] > lo || (v[r] == lo && rank < need)); base += __builtin_popcountll(tm); if (lane == r) mine = mk; }
    }
    if (lane < 32) *(unsigned long long*)(selrow + 2 * lane) = mine;
}
__device__ __forceinline__ void idx_unit(const Ctx& c, int b, int qt) {
    int lane = c.lane; asm volatile("" : "+v"(lane));
    const int w = c.wave, fr = lane & 15, fq = lane >> 4, t0 = 16 * qt, nkb = qt + 1, nk = t0 + 16;
    const size_t mb = (size_t)b * 2048;
    const bf16_t* QI = (const bf16_t*)(c.ws + WS_QI); const bf16_t* KI = (const bf16_t*)(c.ws + WS_KI); const float* WI = (const float*)(c.ws + WS_WI);
    bf16x8 af[4][2][2]; float wt[4][8];
#pragma unroll
    for (int G = 0; G < 4; ++G) {
#pragma unroll
        for (int hl = 0; hl < 2; ++hl)
#pragma unroll
            for (int ks = 0; ks < 2; ++ks) af[G][hl][ks] = *(const bf16x8*)(QI + (mb + t0 + 4 * G + (fr >> 2)) * 512 + 64 * (4 * hl + (fr & 3)) + 32 * ks + 8 * fq);
#pragma unroll
        for (int h = 0; h < 8; ++h) wt[G][h] = WI[(mb + t0 + 4 * G + fq) * 8 + h] * IDX_SCALE;
    }
    LAS float* sc = (LAS float*)c.lds;
    for (int kb = w; kb < nkb; kb += 8) {
        bf16x8 bfr[2];
#pragma unroll
        for (int ks = 0; ks < 2; ++ks) bfr[ks] = *(const bf16x8*)(KI + (mb + 16 * kb + fr) * 64 + 32 * ks + 8 * fq);
        const int key = 16 * kb + fr;
#pragma unroll
        for (int G = 0; G < 4; ++G) {
            f32x4 lo = {0.f, 0.f, 0.f, 0.f}, hi = {0.f, 0.f, 0.f, 0.f};
            lo = __builtin_amdgcn_mfma_f32_16x16x32_bf16(af[G][0][0], bfr[0], lo, 0, 0, 0); lo = __builtin_amdgcn_mfma_f32_16x16x32_bf16(af[G][0][1], bfr[1], lo, 0, 0, 0);
            hi = __builtin_amdgcn_mfma_f32_16x16x32_bf16(af[G][1][0], bfr[0], hi, 0, 0, 0); hi = __builtin_amdgcn_mfma_f32_16x16x32_bf16(af[G][1][1], bfr[1], hi, 0, 0, 0);
            float s = 0.f;
#pragma unroll
            for (int i = 0; i < 4; ++i) { s = fmaf(fmaxf(lo[i], 0.f), wt[G][i], s); s = fmaf(fmaxf(hi[i], 0.f), wt[G][4 + i], s); }
            const int q = 4 * G + fq;
            if (key > t0 + q) s = -INFINITY;
            sc[q * IDX_STRIDE + key] = s;
        }
    }
    __syncthreads();
    unsigned* SEL = (unsigned*)(c.ws + WS_SEL);
    const int nr = (nk + 63) >> 6;
#pragma unroll
    for (int qq = 0; qq < 2; ++qq) { const int q = 2 * w + qq; unsigned* selrow = SEL + (mb + t0 + q) * 64; const LAS float* row = sc + q * IDX_STRIDE;
        if (nr <= 8) select_row<8>(row, nk, lane, selrow); else if (nr <= 16) select_row<16>(row, nk, lane, selrow);
        else if (nr <= 24) select_row<24>(row, nk, lane, selrow); else select_row<32>(row, nk, lane, selrow); }
    __syncthreads();
}
__device__ __forceinline__ void maskfill_unit(const Ctx& c, int b, int qt) {
#pragma unroll
    for (int qq = 0; qq < 2; ++qq) { const int t = 16 * qt + 2 * c.wave + qq; unsigned* selrow = (unsigned*)(c.ws + WS_SEL) + ((size_t)b * 2048 + t) * 64;
        if (c.lane < 32) { const int k0 = 64 * c.lane; unsigned long long mk = 0ull; if (k0 + 63 <= t) mk = ~0ull; else if (k0 <= t) mk = (1ull << (t - k0 + 1)) - 1ull;
            *(unsigned long long*)(selrow + 2 * c.lane) = mk; } }
}

__device__ __forceinline__ void attn_unit(const Ctx& c, int b, int g, int qb) {
    int lane = c.lane; asm volatile("" : "+v"(lane));
    const int w = c.wave, r32 = lane & 31, hh = lane >> 5, head = 4 * g + (w & 3), tq0 = 64 * qb + 32 * (w >> 2), tq = tq0 + r32;
    const size_t mb = (size_t)b * 2048;
    const bf16_t* Q = (const bf16_t*)(c.ws + WS_Q); const bf16_t* KB = (const bf16_t*)(c.ws + WS_KB); const bf16_t* VT = (const bf16_t*)(c.ws + WS_VT) + (size_t)(b * 2 + g) * 64 * 2048;
    const unsigned* SEL = (const unsigned*)(c.ws + WS_SEL) + (mb + tq) * 64;
    bf16x8 qf[4];
#pragma unroll
    for (int ks = 0; ks < 4; ++ks) qf[ks] = *(const bf16x8*)(Q + (mb + tq) * 512 + 64 * head + 16 * ks + 8 * hh);
    f32x16 o0 = {}, o1 = {}; float mrun = -1e30f, lrun = 0.f;
    const int ntiles = (tq0 >> 5) + 1;
    for (int kt = 0; kt < ntiles; ++kt) {
        f32x16 s = {};
#pragma unroll
        for (int ks = 0; ks < 4; ++ks) { const bf16x8 kf = *(const bf16x8*)(KB + (mb + 32 * kt + r32) * 128 + 64 * g + 16 * ks + 8 * hh);
            s = __builtin_amdgcn_mfma_f32_32x32x16_bf16(kf, qf[ks], s, 0, 0, 0); }
        const unsigned mw = SEL[kt];
        float rmax = -INFINITY;
#pragma unroll
        for (int i = 0; i < 16; ++i) { const int kl = (i & 3) + 8 * (i >> 2) + 4 * hh; if (!((mw >> kl) & 1u)) s[i] = -INFINITY; rmax = fmaxf(rmax, s[i]); }
        rmax = xhalf_max(rmax);
        const float mnew = fmaxf(mrun, rmax), alpha = exp2f(mrun - mnew);
        float rs = 0.f; float p[16];
#pragma unroll
        for (int i = 0; i < 16; ++i) { p[i] = exp2f(s[i] - mnew); rs += p[i]; }
        rs = xhalf_sum(rs);
        lrun = lrun * alpha + rs; mrun = mnew;
#pragma unroll
        for (int i = 0; i < 16; ++i) { o0[i] *= alpha; o1[i] *= alpha; }
#pragma unroll
        for (int sN = 0; sN < 2; ++sN) {
            bf16x8 pf;
            { const unsigned a0 = pkbf(p[8 * sN + 0], p[8 * sN + 1]), a1 = pkbf(p[8 * sN + 2], p[8 * sN + 3]), a2 = pkbf(p[8 * sN + 4], p[8 * sN + 5]), a3 = pkbf(p[8 * sN + 6], p[8 * sN + 7]);
              const u32x4 pw = {a0, a1, a2, a3}; pf = __builtin_bit_cast(bf16x8, pw); }
#pragma unroll
            for (int dt = 0; dt < 2; ++dt) {
                const bf16_t* vp = VT + (size_t)(32 * dt + r32) * 2048 + 32 * kt + 16 * sN + 4 * hh;
                const u32x2 va = *(const u32x2*)vp, vb = *(const u32x2*)(vp + 8);
                const u32x4 vw = {va[0], va[1], vb[0], vb[1]}; const bf16x8 vf = __builtin_bit_cast(bf16x8, vw);
                if (dt == 0) o0 = __builtin_amdgcn_mfma_f32_32x32x16_bf16(vf, pf, o0, 0, 0, 0); else o1 = __builtin_amdgcn_mfma_f32_32x32x16_bf16(vf, pf, o1, 0, 0, 0);
            }
        }
    }
    const float rl = 1.0f / lrun;
    bf16_t* Y = (bf16_t*)(c.ws + WS_Y) + (mb + tq) * D + 512 + 64 * head;
#pragma unroll
    for (int i4 = 0; i4 < 4; ++i4) { const int d = 8 * i4 + 4 * hh;
        *(u32x2*)(Y + d) = (u32x2){pkbf(o0[4 * i4] * rl, o0[4 * i4 + 1] * rl), pkbf(o0[4 * i4 + 2] * rl, o0[4 * i4 + 3] * rl)};
        *(u32x2*)(Y + 32 + d) = (u32x2){pkbf(o1[4 * i4] * rl, o1[4 * i4 + 1] * rl), pkbf(o1[4 * i4 + 2] * rl, o1[4 * i4 + 3] * rl)}; }
}

template <class Epi>
__device__ __forceinline__ void run_gemm(const Ctx& c, const bf16_t* A, const bf16_t* Bt, int N, int K, const Epi& E) {
    asm volatile("" : "+s"(K));
    pg8::Gemm g{A, Bt, M, N, K}; pg8::StaticOrder S; S.init(M, N, c.G, c.bid);
    pg8::gemm_phase<Epi, pg8::StaticOrder, true, true>(c.lds, g, S, E);
}

#ifndef DIS
#define DIS 0
#endif
template <int S>
__device__ __forceinline__ void run_stage(const Ctx& c, int L) {
    if constexpr ((DIS >> S) & 1) return;
    unsigned char* ws = c.ws; unsigned char* wl = ws + WS_W + (size_t)L * W_LAYER; float* H = c.a->out; bf16_t* HN = (bf16_t*)(ws + WS_HN);
    if constexpr (S == 10) { prologue(c); }
    if constexpr (S == 0) {
        EpiProj E{(bf16_t*)(ws + WS_U), (bf16_t*)(ws + WS_GRG), (bf16_t*)(ws + WS_Q), (bf16_t*)(ws + WS_KB), (bf16_t*)(ws + WS_VT), (bf16_t*)(ws + WS_QI), (bf16_t*)(ws + WS_KI),
                  (float*)(ws + WS_XRG), (float*)(ws + WS_WI), (const float*)(ws + WS_ROPE)};
        run_gemm(c, HN, (const bf16_t*)(wl + OW_IN), N_INP, D, E);
    }
    if constexpr (S == 1) {
        for (int u = c.bid; u < 1536; u += c.G) {
            if (u < 896) idx_unit(c, u & 7, 127 - (u >> 3));
            else if (u < 1024) maskfill_unit(c, (u - 896) & 7, (u - 896) >> 3);
            else if (u < 1280) s5_pass1_unit(c, L, u - 1024);
            else rg_pass1_unit(c, L, u - 1280);
        }
    }
    if constexpr (S == 2) {
        for (int u = c.bid; u < 832; u += c.G) {
            if (u < 512) { const int r = u >> 4, inner = u & 15; attn_unit(c, inner >> 1, inner & 1, u < 256 ? 31 - r : r - 16); }
            else if (u < 768) s5_pass2_unit(c, L, u - 512);
            else rg_scan_unit(c, u - 768);
        }
    }
    if constexpr (S == 3) { EpiResid E{H}; run_gemm(c, (const bf16_t*)(ws + WS_Y), (const bf16_t*)(wl + OW_OUT), D, D, E); }
    if constexpr (S == 4) ln_pass(c, H, INF_(24, float) + L * D, INF_(25, float) + L * D, HN);
    if constexpr (S == 5) { EpiStoreBf16 E{(bf16_t*)(ws + WS_Y), D}; run_gemm(c, (const bf16_t*)(ws + WS_PB) + (size_t)L * M * 256, (const bf16_t*)(wl + OW_PPROJ), D, 256, E); }
    if constexpr (S == 6) { EpiSwiglu E{(bf16_t*)(ws + WS_ACT)}; run_gemm(c, HN, (const bf16_t*)(wl + OW_UP), NUP, D, E); }
    if constexpr (S == 7) { EpiPle E{(bf16_t*)(ws + WS_Y)}; run_gemm(c, HN, (const bf16_t*)(wl + OW_GATE), D, D, E); }
    if constexpr (S == 8) { EpiDown E{H, (const bf16_t*)(ws + WS_Y)}; run_gemm(c, (const bf16_t*)(ws + WS_ACT), (const bf16_t*)(wl + OW_DOWN), D, DFF, E); }
    if constexpr (S == 9) ln_pass(c, H, INF_(30, float) + L * D, INF_(31, float) + L * D, HN);
}
constexpr int N_GROUPS = 1 + 8 * DEPTH;
#define GAS __attribute__((address_space(1)))
constexpr size_t WS_CTL = 0, CTL_ZERO_BYTES = 1 * MiB;
constexpr int CW_BAR = 4096;
constexpr int MISC_OFF = 143360;
static_assert(MISC_OFF + 64 <= LDS_BYTES && 16 * IDX_STRIDE * 4 <= MISC_OFF, "lds map");
#define XB_TMO      128
#define XB_XCNT(j)  (256  + 64 * (j))
#define XB_XSUB(j)  (1280 + 64 * (j))
#define XB_XGEN(j)  (2304 + 64 * (j))
#define XB_TOP      3328
#define XB_TOPGEN   3392
#define XCD_BAR_WORDS 3456
#define XB_SPIN_CAP (1u << 18)

__device__ __forceinline__ unsigned xb_ld(unsigned* p)              { return __hip_atomic_load(p, __ATOMIC_RELAXED, __HIP_MEMORY_SCOPE_AGENT); }
__device__ __forceinline__ unsigned xb_add(unsigned* p, unsigned v) { return __hip_atomic_fetch_add(p, v, __ATOMIC_RELAXED, __HIP_MEMORY_SCOPE_AGENT); }
__device__ __forceinline__ unsigned xb_xcc_id() { return (unsigned)__builtin_amdgcn_s_getreg((3 << 11) | 20) & 0xFu; }
#define XB_SPIN(cond, bar) do { unsigned _sp = 0; while (cond) { __builtin_amdgcn_s_sleep(1); \
    if ((++_sp & 255u) == 0u) { if (xb_ld(&(bar)[XB_TMO])) break; if (_sp > XB_SPIN_CAP) { atomicAdd(&(bar)[XB_TMO], 1u); break; } } } } while (0)

struct XcdBarrier {
    unsigned* bar; unsigned x;
    volatile LAS unsigned* st;
};

__device__ __forceinline__ XcdBarrier xcd_barrier_post(unsigned* bar, volatile LAS unsigned* st) {
    XcdBarrier b; b.bar = bar; b.x = xb_xcc_id(); b.st = st;
    if (threadIdx.x == 0) (void)xb_add(&bar[XB_XCNT(b.x)], 1u);
    return b;
}
__device__ __forceinline__ void xcd_barrier_complete(unsigned* bar, unsigned x, unsigned& nloc, unsigned& nx) {
    const unsigned G = gridDim.x * gridDim.y * gridDim.z;
    unsigned sum, cnt, mine, sp = 0u;
    for (;;) {
        sum = 0u; cnt = 0u; mine = 0u;
#pragma unroll
        for (unsigned j = 0; j < 16; ++j) { const unsigned c = xb_ld(&bar[XB_XCNT(j)]); sum += c; cnt += (c > 0u) ? 1u : 0u; mine = (j == x) ? c : mine; }
        if (sum == G) break;
        __builtin_amdgcn_s_sleep(1);
        if ((++sp & 255u) == 0u) { if (xb_ld(&bar[XB_TMO])) break; if (sp > XB_SPIN_CAP) { atomicAdd(&bar[XB_TMO], 1u); break; } }
    }
    nloc = mine > 0u ? mine : 1u; nx = cnt > 0u ? cnt : 1u;
}

__device__ __forceinline__ void xcd_barrier(const XcdBarrier& b) {
    asm volatile("s_waitcnt vmcnt(0)" ::: "memory");
    __syncthreads();
    if (threadIdx.x == 0) {
        unsigned* bar = b.bar;
        __builtin_amdgcn_s_waitcnt(0);
        unsigned nloc = b.st[0], nx = b.st[1];
        if (nloc == 0u) { xcd_barrier_complete(bar, b.x, nloc, nx); b.st[0] = nloc; b.st[1] = nx; }
        const unsigned old = xb_add(&bar[XB_XSUB(b.x)], 1u);
        const unsigned gen = old / nloc;
        if (old + 1u == (gen + 1u) * nloc) {
            __builtin_amdgcn_fence(__ATOMIC_RELEASE, "agent");
            asm volatile("s_waitcnt vmcnt(0)" ::: "memory");
            const unsigned og = xb_add(&bar[XB_TOP], 1u);
            const unsigned tg = og / nx;
            if (og + 1u == (tg + 1u) * nx) xb_add(&bar[XB_TOPGEN], 1u);
            else XB_SPIN(xb_ld(&bar[XB_TOPGEN]) == tg, bar);
            __builtin_amdgcn_fence(__ATOMIC_ACQUIRE, "agent");
            xb_add(&bar[XB_XGEN(b.x)], 1u);
            asm volatile("s_waitcnt vmcnt(0)" ::: "memory");
        } else {
            XB_SPIN(xb_ld(&bar[XB_XGEN(b.x)]) == gen, bar);
            __builtin_amdgcn_fence(__ATOMIC_ACQUIRE, "agent");
            asm volatile("s_waitcnt vmcnt(0)" ::: "memory");
        }
    }
    __syncthreads();
}

#define MK_CTX() Ctx c; c.lds = (LAS unsigned char*)lds_raw; c.ldsg = lds_raw; \
        { unsigned long long kp = (unsigned long long)__builtin_amdgcn_kernarg_segment_ptr(); asm volatile("" : "+s"(kp)); c.a = (KArgs)kp; } \
        c.ws = c.a->ws; { int t = threadIdx.x; asm volatile("" : "+v"(t)); c.tid = t; } \
        c.lane = c.tid & 63; c.wave = __builtin_amdgcn_readfirstlane(c.tid >> 6); c.bid = blockIdx.x; c.G = gridDim.x;
#define MK_GROUP(k, body) do { if (lo <= (k) && (k) < hi) { { MK_CTX(); body; } if ((k) + 1 < hi) { if ((k) == 0) grid.sync(); else xcd_barrier(bar); } } } while (0)
__global__ void __launch_bounds__(NTHREADS, 2) fwd_kernel(Args args) {
    extern __shared__ __attribute__((aligned(16))) unsigned char lds_raw[];
    cg::grid_group grid = cg::this_grid();
    const int lo = args.ph_lo, hi = args.ph_hi;
    if (threadIdx.x < 16) ((LAS unsigned*)(lds_raw + MISC_OFF))[threadIdx.x] = 0u;
    __syncthreads();
    XcdBarrier bar; bar.bar = nullptr; bar.x = 0; bar.st = nullptr;
    if (hi - lo > 1) bar = xcd_barrier_post((unsigned*)(args.ws + WS_CTL) + CW_BAR, (volatile LAS unsigned*)((LAS unsigned char*)lds_raw + MISC_OFF));
    MK_GROUP(0, run_stage<10>(c, 0));
#pragma unroll
    for (int L = 0; L < DEPTH; ++L) {
        const int k0 = 1 + 8 * L;
        MK_GROUP(k0 + 0, run_stage<0>(c, L));
        MK_GROUP(k0 + 1, run_stage<1>(c, L));
        MK_GROUP(k0 + 2, run_stage<2>(c, L));
        MK_GROUP(k0 + 3, run_stage<3>(c, L));
        MK_GROUP(k0 + 4, run_stage<4>(c, L));
        MK_GROUP(k0 + 5, run_stage<5>(c, L); run_stage<6>(c, L));
        MK_GROUP(k0 + 6, run_stage<7>(c, L); run_stage<8>(c, L));
        MK_GROUP(k0 + 7, run_stage<9>(c, L));
    }
}
#ifndef MK_PER_PHASE
#define MK_PER_PHASE 0
#endif
extern "C" void kernel_launch(void* const* d_in, const int* in_sizes, int n_in, void* d_out, int out_size, void* d_ws, size_t ws_size, hipStream_t stream) {
    static int grid = 0;
    if (grid == 0) {
        if (n_in != 32 || out_size != M * D || ws_size < WS_END) { fprintf(stderr, "kernel_launch: unexpected shapes (n_in %d out %d ws %zu)\n", n_in, out_size, ws_size); grid = -1; return; }
        int dev = 0, cus = 0, per_cu = 0;
        (void)hipGetDevice(&dev); (void)hipDeviceGetAttribute(&cus, hipDeviceAttributeMultiprocessorCount, dev);
        (void)hipFuncSetAttribute((const void*)fwd_kernel, hipFuncAttributeMaxDynamicSharedMemorySize, LDS_BYTES);
        (void)hipOccupancyMaxActiveBlocksPerMultiprocessor(&per_cu, (const void*)fwd_kernel, NTHREADS, LDS_BYTES);
        if (per_cu < 1) { fprintf(stderr, "kernel_launch: occupancy query says %d blocks/CU\n", per_cu); }
        (void)hipGetLastError();
        grid = cus;
    }
    if (grid < 0) return;
    Args a{};
    for (int i = 0; i < 32; ++i) a.in[i] = d_in[i];
    a.out = (float*)d_out; a.ws = (unsigned char*)d_ws;
#if MK_PER_PHASE
    for (int ph = 0; ph < N_GROUPS; ++ph) { a.ph_lo = ph; a.ph_hi = ph + 1; hipLaunchKernelGGL(fwd_kernel, dim3(grid), dim3(NTHREADS), LDS_BYTES, stream, a); }
#else
    a.ph_lo = 0; a.ph_hi = N_GROUPS;
    if (hipMemsetAsync((char*)d_ws + WS_CTL, 0, CTL_ZERO_BYTES, stream) != hipSuccess) { fprintf(stderr, "kernel_launch: memset failed\n"); return; }
    void* kargs[] = {&a};
    hipError_t e = hipLaunchCooperativeKernel((const void*)fwd_kernel, dim3(grid), dim3(NTHREADS), kargs, LDS_BYTES, stream);
    if (e != hipSuccess) fprintf(stderr, "cooperative launch failed: %s (grid %d)\n", hipGetErrorString(e), grid);
#endif
}
```

```cpp
#include <hip/hip_runtime.h>
#include <hip/hip_cooperative_groups.h>
#include <cstdio>
#include <cstdint>
namespace cg = cooperative_groups;
namespace pg8 {
#define PG8_LAS __attribute__((address_space(3)))
typedef unsigned short bf16_t;
typedef short bf16x8 __attribute__((ext_vector_type(8)));
typedef float f32x4 __attribute__((ext_vector_type(4)));
typedef unsigned u32x4 __attribute__((ext_vector_type(4)));
constexpr int BM = 256, BK = 64, HALF = 128, HTB = HALF * BK * 2  , STAGE_BYTES = 8 * HTB, NXCD = 8, WGM = 8;

__host__ __device__ __forceinline__ int lds_byte(int r, int c) { const int st = (r >> 4) * 2 + (c >> 5), rr = r & 15, cc = c & 31, ob = rr * 64 + cc * 2; return st * 1024 + (ob ^ (((ob >> 9) & 1) << 5)); }
__host__ __device__ __forceinline__ void stage_rc(int b, int& R, int& C) { const int st = b / 1024, sb = b % 1024, swz = sb ^ (((sb >> 9) & 1) << 5); R = (st >> 1) * 16 + swz / 64; C = (st & 1) * 32 + (swz % 64) / 2; }
__host__ __device__ __forceinline__ int perm32(int rho) { const int n = rho >> 4, i = rho & 15; return 8 * (i >> 2) + 4 * n + (i & 3); }

struct Unit { int pm, pn; };
struct Gemm { const bf16_t* A; const bf16_t* Bt; int M, N, K; };

struct StaticOrder {
    int nM, nN, nwg, G, c;
    __host__ __device__ void init(int M, int N, int G_, int c_) { nM = M / BM; nN = N / BM; nwg = nM * nN; G = G_; c = c_; }
    __host__ __device__ bool next(int i, Unit& u) const {
        const long L = (long)i * G + c; if (L >= nwg) return false;
        int wgid = (int)L; { const int q = nwg / NXCD, r = nwg % NXCD, xcd = wgid % NXCD, off = wgid / NXCD; wgid = (xcd < r ? xcd * (q + 1) : r * (q + 1) + (xcd - r) * q) + off; }
        const int nig = WGM * nN, gid = wgid / nig, fm = gid * WGM, gsz = (nM - fm) < WGM ? (nM - fm) : WGM;
        u.pm = fm + ((wgid % nig) % gsz); u.pn = (wgid % nig) / gsz; return true;
    }
    __device__ __forceinline__ void a_ready(const Unit&) const {}
    __device__ __forceinline__ void done(const Unit&) const {}
};

template <class Epi, class Sched, bool ALIGN_EPI = false, bool SP2 = false>
__device__ __forceinline__ void gemm_phase(PG8_LAS unsigned char* lds, const Gemm g, const Sched& S, const Epi& E) {
    int tid = threadIdx.x; asm volatile("" : "+v"(tid));
    const int wid = __builtin_amdgcn_readfirstlane(tid >> 6), lane = tid & 63, wr = wid >> 2, wc = wid & 3, fr = lane & 15, fq = lane >> 4;
    const int K = g.K, nt = K / BK;
    unsigned voffA[2], voffB[2];
#pragma unroll
    for (int i = 0; i < 2; ++i) { int R, C; stage_rc(tid * 16 + i * 8192, R, C); const int Rb = Epi::PERM ? ((R & ~31) + perm32(R & 31)) : R;
        voffA[i] = (unsigned)(R * K + C) * 2u; voffB[i] = (unsigned)(Rb * K + C) * 2u; }
    const size_t kstep = (size_t)(BK * 2);
    const size_t hstep = (size_t)HALF * K * 2;
    const size_t tstep = 2 * hstep;
    const unsigned ldsw = (unsigned)wid * 1024u;
    const int aoff = lds_byte(wr * 64 + fr, fq * 8), boff = lds_byte(wc * 32 + fr, fq * 8);
#define PG8_SA(b, h) (((b) * 2 + (h)) * HTB)
#define PG8_SB(b, h) ((4 + (b) * 2 + (h)) * HTB)
#define PG8_STAGE(bufoff, gbase, voff) do { _Pragma("unroll") for (int _i = 0; _i < 2; ++_i) \
        __builtin_amdgcn_global_load_lds((const unsigned*)((const char*)(gbase) + (voff)[_i]), (PG8_LAS unsigned*)(lds + (bufoff) + ldsw + _i * 8192), 16, 0, 0); } while (0)
#define PG8_LDA(dst, b, h) do { _Pragma("unroll") for (int m = 0; m < 4; ++m) _Pragma("unroll") for (int k = 0; k < 2; ++k) dst[m][k] = *(const PG8_LAS bf16x8*)(lds + PG8_SA(b, h) + aoff + m * 2048 + k * 1024); } while (0)
#define PG8_LDB(dst, b, h) do { _Pragma("unroll") for (int n = 0; n < 2; ++n) _Pragma("unroll") for (int k = 0; k < 2; ++k) dst[n][k] = *(const PG8_LAS bf16x8*)(lds + PG8_SB(b, h) + boff + n * 2048 + k * 1024); } while (0)
#define PG8_MMA(ai, bj, At, Bt) do { __builtin_amdgcn_s_setprio(1); _Pragma("unroll") for (int m = 0; m < 4; ++m) _Pragma("unroll") for (int n = 0; n < 2; ++n) _Pragma("unroll") for (int k = 0; k < 2; ++k) \
        acc[ai][bj][m][n] = __builtin_amdgcn_mfma_f32_16x16x32_bf16(Bt[n][k], At[m][k], acc[ai][bj][m][n], 0, 0, 0); __builtin_amdgcn_s_setprio(0); } while (0)
#define PG8_WAIT_V(n) asm volatile("s_waitcnt vmcnt(" #n ")" ::: "memory")
#define PG8_WAIT_L(n) asm volatile("s_waitcnt lgkmcnt(" #n ")" ::: "memory")
#define PG8_BAR __builtin_amdgcn_s_barrier()
#define PG8_SCHED __builtin_amdgcn_sched_barrier(0)
    Unit cur, nxt; int ui = 0;
    if (!S.next(0, cur)) return;
    f32x4 acc[2][2][4][2];
#pragma unroll
    for (int a = 0; a < 2; ++a)
#pragma unroll
        for (int b = 0; b < 2; ++b)
#pragma unroll
            for (int m = 0; m < 4; ++m)
#pragma unroll
                for (int n = 0; n < 2; ++n) acc[a][b][m][n] = (f32x4){0.f, 0.f, 0.f, 0.f};
    bf16x8 At[4][2], B0[2][2], B1[2][2];
    const char* cA = (const char*)g.A + (size_t)cur.pm * tstep; const char* cB = (const char*)g.Bt + (size_t)cur.pn * tstep;
    S.a_ready(cur);
    if constexpr (SP2) {
        PG8_STAGE(PG8_SB(0, 0), cB, voffB); PG8_STAGE(PG8_SB(0, 1), cB + hstep, voffB); PG8_STAGE(PG8_SA(0, 0), cA, voffA); PG8_STAGE(PG8_SA(0, 1), cA + hstep, voffA);
        if (wr == 1) PG8_BAR;
        PG8_WAIT_V(2); PG8_BAR;
        PG8_STAGE(PG8_SB(1, 0), cB + kstep, voffB); PG8_STAGE(PG8_SA(1, 0), cA + kstep, voffA); PG8_STAGE(PG8_SB(1, 1), cB + hstep + kstep, voffB);
        PG8_WAIT_V(6); PG8_BAR;
    } else {
        PG8_STAGE(PG8_SB(0, 0), cB, voffB); PG8_STAGE(PG8_SA(0, 0), cA, voffA); PG8_STAGE(PG8_SB(0, 1), cB + hstep, voffB); PG8_STAGE(PG8_SA(0, 1), cA + hstep, voffA);
        if (wr == 1) PG8_BAR;
        PG8_WAIT_V(4); PG8_BAR;
        PG8_STAGE(PG8_SB(1, 0), cB + kstep, voffB); PG8_STAGE(PG8_SA(1, 0), cA + kstep, voffA); PG8_STAGE(PG8_SB(1, 1), cB + hstep + kstep, voffB);
        PG8_WAIT_V(6); PG8_BAR;
    }
    for (;;) {
        const bool has_next = S.next(ui + 1, nxt);
        const char* nA = has_next ? (const char*)g.A + (size_t)nxt.pm * tstep : cA; const char* nB = has_next ? (const char*)g.Bt + (size_t)nxt.pn * tstep : cB;
        for (int t = 0; t < nt; t += 2) {
            const bool last = (t == nt - 2);
            const char* a1 = cA + (size_t)(t + 1) * kstep;
            const char* a2 = last ? nA : cA + (size_t)(t + 2) * kstep; const char* b2 = last ? nB : cB + (size_t)(t + 2) * kstep;
            const char* a3 = a2 + kstep; const char* b3 = b2 + kstep;
            if (last && has_next) S.a_ready(nxt);
            if constexpr (SP2) {
            PG8_LDB(B0, 0, 0); PG8_LDB(B1, 0, 1); PG8_SCHED; PG8_LDA(At, 0, 0); PG8_STAGE(PG8_SA(1, 1), a1 + hstep, voffA);
            PG8_WAIT_V(8); PG8_WAIT_L(0); PG8_BAR; PG8_MMA(0, 0, At, B0); PG8_MMA(0, 1, At, B1); PG8_BAR; PG8_SCHED;
            PG8_LDA(At, 0, 1); PG8_STAGE(PG8_SB(0, 0), b2, voffB); PG8_STAGE(PG8_SB(0, 1), b2 + hstep, voffB); PG8_STAGE(PG8_SA(0, 0), a2, voffA);
            PG8_WAIT_V(8); PG8_WAIT_L(0); PG8_BAR; PG8_MMA(1, 0, At, B0); PG8_MMA(1, 1, At, B1); PG8_BAR; PG8_SCHED;
            PG8_LDB(B0, 1, 0); PG8_LDB(B1, 1, 1); PG8_SCHED; PG8_LDA(At, 1, 0); PG8_STAGE(PG8_SA(0, 1), a2 + hstep, voffA);
            PG8_WAIT_V(8); PG8_WAIT_L(0); PG8_BAR; PG8_MMA(0, 0, At, B0); PG8_MMA(0, 1, At, B1); PG8_BAR; PG8_SCHED;
            PG8_LDA(At, 1, 1); PG8_STAGE(PG8_SB(1, 0), b3, voffB); PG8_STAGE(PG8_SB(1, 1), b3 + hstep, voffB); PG8_STAGE(PG8_SA(1, 0), a3, voffA);
            PG8_WAIT_V(8); PG8_WAIT_L(0); PG8_BAR; PG8_MMA(1, 0, At, B0); PG8_MMA(1, 1, At, B1); PG8_BAR; PG8_SCHED;
            } else {
            PG8_LDB(B0, 0, 0); PG8_SCHED; PG8_LDA(At, 0, 0); PG8_STAGE(PG8_SA(1, 1), a1 + hstep, voffA);
            PG8_WAIT_L(8); PG8_BAR; PG8_WAIT_L(0); PG8_MMA(0, 0, At, B0); PG8_BAR; PG8_SCHED;
            PG8_LDB(B1, 0, 1); PG8_STAGE(PG8_SB(0, 0), b2, voffB);
            PG8_BAR; PG8_WAIT_L(0); PG8_MMA(0, 1, At, B1); PG8_BAR;
            PG8_LDA(At, 0, 1); PG8_STAGE(PG8_SA(0, 0), a2, voffA);
            PG8_BAR; PG8_WAIT_L(0); PG8_MMA(1, 0, At, B0); PG8_BAR; PG8_SCHED;
            PG8_STAGE(PG8_SB(0, 1), b2 + hstep, voffB);
            PG8_WAIT_V(6); PG8_BAR; PG8_MMA(1, 1, At, B1); PG8_BAR;
            PG8_LDB(B0, 1, 0); PG8_SCHED; PG8_LDA(At, 1, 0); PG8_STAGE(PG8_SA(0, 1), a2 + hstep, voffA);
            PG8_WAIT_L(8); PG8_BAR; PG8_WAIT_L(0); PG8_MMA(0, 0, At, B0); PG8_BAR; PG8_SCHED;
            PG8_LDB(B1, 1, 1); PG8_STAGE(PG8_SB(1, 0), b3, voffB);
            PG8_BAR; PG8_WAIT_L(0); PG8_MMA(0, 1, At, B1); PG8_BAR;
            PG8_LDA(At, 1, 1); PG8_STAGE(PG8_SA(1, 0), a3, voffA);
            PG8_BAR; PG8_WAIT_L(0); PG8_MMA(1, 0, At, B0); PG8_BAR; PG8_SCHED;
            PG8_STAGE(PG8_SB(1, 1), b3 + hstep, voffB);
            PG8_WAIT_V(6); PG8_BAR; PG8_MMA(1, 1, At, B1); PG8_BAR;
            }
        }
        if constexpr (ALIGN_EPI) { if (wr == 0) PG8_BAR; }
        if constexpr (!Epi::AFTER_DRAIN) { E(acc, cur, wr, wc, fr, fq); S.done(cur); }
        if (!has_next) break;
#pragma unroll
        for (int a = 0; a < 2; ++a)
#pragma unroll
            for (int b = 0; b < 2; ++b)
#pragma unroll
                for (int m = 0; m < 4; ++m)
#pragma unroll
                    for (int n = 0; n < 2; ++n) acc[a][b][m][n] = (f32x4){0.f, 0.f, 0.f, 0.f};
        cur = nxt; cA = nA; cB = nB; ++ui;
        if constexpr (ALIGN_EPI) { if (wr == 1) PG8_BAR; }
    }
    PG8_WAIT_V(0);
    if constexpr (!ALIGN_EPI) { if (wr == 0) PG8_BAR; }
    PG8_BAR;
    if constexpr (Epi::AFTER_DRAIN) { E.fused(acc, cur, wr, wc, fr, fq, lds, wid, lane); S.done(cur); }
#undef PG8_SA
#undef PG8_SB
#undef PG8_STAGE
#undef PG8_LDA
#undef PG8_LDB
#undef PG8_MMA
#undef PG8_WAIT_V
#undef PG8_WAIT_L
#undef PG8_BAR
#undef PG8_SCHED
}
}

#define LAS __attribute__((address_space(3)))
typedef unsigned short bf16_t;
typedef short bf16x8 __attribute__((ext_vector_type(8)));
typedef float f32x4 __attribute__((ext_vector_type(4)));
typedef float f32x16 __attribute__((ext_vector_type(16)));
typedef unsigned u32x2 __attribute__((ext_vector_type(2)));
typedef unsigned u32x4 __attribute__((ext_vector_type(4)));
typedef float f32x2_t __attribute__((ext_vector_type(2)));
typedef __bf16 bf16x2_t __attribute__((ext_vector_type(2)));

constexpr int BATCH = 8, SEQ = 2048, M = BATCH * SEQ, D = 1024, DEPTH = 2;
constexpr int N_IN = 2120, N_INP = 2304, DFF = 2816, NUP = 2 * DFF;
constexpr float ALPHA = 1.4142135623730951f;
constexpr float LN_EPS = 1e-5f;
constexpr float QSCALE = 0.125f * 1.4426950408889634f;
constexpr float IDX_SCALE = 0.04419417382415922f;
constexpr int NTHREADS = 512, NWAVES = 8;
constexpr int LDS_BYTES = 147456;

constexpr size_t MiB = 1u << 20;
constexpr size_t WS_W = 2 * MiB, W_LAYER = 26 * MiB;
constexpr size_t OW_IN = 0, OW_OUT = OW_IN + (size_t)N_INP * D * 2, OW_UP = OW_OUT + (size_t)D * D * 2, OW_DOWN = OW_UP + (size_t)NUP * D * 2,
                 OW_GATE = OW_DOWN + (size_t)D * DFF * 2, OW_PPROJ = OW_GATE + (size_t)D * D * 2, OW_GLU = OW_PPROJ + (size_t)D * 256 * 2, OW_END = OW_GLU + 256 * 256 * 2;
static_assert(OW_END <= W_LAYER, "weights per layer");
constexpr size_t WS_TAB = 54 * MiB, TAB_LAYER = 1 * MiB;
constexpr size_t TAB_LAM = 0, TAB_BBR = 65536, TAB_BBI = 131072, TAB_CM = 196608, TAB_SP = 262144;
constexpr size_t WS_ROPE = 56 * MiB, WS_HN = 60 * MiB, WS_PB = 92 * MiB, WS_SEL = 108 * MiB, WS_S5S = 112 * MiB, WS_Y = 114 * MiB;
constexpr size_t WS_U = 146 * MiB, WS_GRG = 154 * MiB, WS_XRG = 162 * MiB, WS_Q = 178 * MiB, WS_QI = 194 * MiB, WS_KB = 210 * MiB, WS_VT = 214 * MiB,
                 WS_KI = 218 * MiB, WS_WI = 220 * MiB, WS_RA = 222 * MiB, WS_RB = 238 * MiB, WS_ACT = 146 * MiB, WS_END = 256 * MiB;
static_assert(WS_ACT + (size_t)M * DFF * 2 <= WS_END, "act overlay");

__device__ __forceinline__ unsigned pkbf(float lo, float hi) { f32x2_t v = {lo, hi}; bf16x2_t b = __builtin_convertvector(v, bf16x2_t); return __builtin_bit_cast(unsigned, b); }
__device__ __forceinline__ float bf2f(unsigned short x) { return __uint_as_float((unsigned)x << 16); }
__device__ __forceinline__ float bflo(unsigned w) { return __uint_as_float(w << 16); }
__device__ __forceinline__ float bfhi(unsigned w) { return __uint_as_float(w & 0xffff0000u); }
__device__ __forceinline__ float sigmoidf_(float x) { return 1.0f / (1.0f + __expf(-x)); }
__device__ __forceinline__ float gelu_tanh(float x) { const float u = 0.7978845608028654f * (x + 0.044715f * x * x * x); return 0.5f * x * (1.0f + tanhf(u)); }
template <int CTRL> __device__ __forceinline__ float dppf(float v) { return __builtin_bit_cast(float, __builtin_amdgcn_update_dpp(0, __builtin_bit_cast(int, v), CTRL, 0xf, 0xf, true)); }
template <int CTRL> __device__ __forceinline__ int dppi(int v) { return __builtin_amdgcn_update_dpp(0, v, CTRL, 0xf, 0xf, true); }
__device__ __forceinline__ float rdl(float v, int l) { return __builtin_bit_cast(float, __builtin_amdgcn_readlane(__builtin_bit_cast(int, v), l)); }
__device__ __forceinline__ float wave_sum(float v) {
    v += dppf<0xB1>(v); v += dppf<0x4E>(v); v += dppf<0x141>(v); v += dppf<0x140>(v);
    return (rdl(v, 0) + rdl(v, 16)) + (rdl(v, 32) + rdl(v, 48));
}
__device__ __forceinline__ float wave_max(float v) {
    v = fmaxf(v, dppf<0xB1>(v)); v = fmaxf(v, dppf<0x4E>(v)); v = fmaxf(v, dppf<0x141>(v)); v = fmaxf(v, dppf<0x140>(v));
    return fmaxf(fmaxf(rdl(v, 0), rdl(v, 16)), fmaxf(rdl(v, 32), rdl(v, 48)));
}
__device__ __forceinline__ float wave_min(float v) {
    v = fminf(v, dppf<0xB1>(v)); v = fminf(v, dppf<0x4E>(v)); v = fminf(v, dppf<0x141>(v)); v = fminf(v, dppf<0x140>(v));
    return fminf(fminf(rdl(v, 0), rdl(v, 16)), fminf(rdl(v, 32), rdl(v, 48)));
}
__device__ __forceinline__ int wave_sum_i(int v) {
    v += dppi<0xB1>(v); v += dppi<0x4E>(v); v += dppi<0x141>(v); v += dppi<0x140>(v);
    return (__builtin_amdgcn_readlane(v, 0) + __builtin_amdgcn_readlane(v, 16)) + (__builtin_amdgcn_readlane(v, 32) + __builtin_amdgcn_readlane(v, 48));
}
__device__ __forceinline__ float xhalf_max(float v) { auto rr = __builtin_amdgcn_permlane32_swap(__float_as_uint(v), __float_as_uint(v), false, false); return fmaxf(__uint_as_float(rr[0]), __uint_as_float(rr[1])); }
__device__ __forceinline__ float xhalf_sum(float v) { auto rr = __builtin_amdgcn_permlane32_swap(__float_as_uint(v), __float_as_uint(v), false, false); return __uint_as_float(rr[0]) + __uint_as_float(rr[1]); }

using pg8::Unit;
struct EpiProj {
    static constexpr bool PERM = false, AFTER_DRAIN = false;
    bf16_t *U, *GRG, *Q, *KB, *VT, *QI, *KI; float *XRG, *WI; const float* ROPE;
    __device__ __forceinline__ void rope_half(const f32x4 (&acc)[2][2][4][2], int bj, const Unit& u, int wr, int wc, int fr, int fq, bf16_t* base, int ld, float sc) const {
        const int d0 = 16 * (wc & 1) + 4 * fq, hdl = wc >> 1;
#pragma unroll
        for (int ai = 0; ai < 2; ++ai)
#pragma unroll
            for (int m = 0; m < 4; ++m) {
                const int row = u.pm * 256 + ai * 128 + wr * 64 + m * 16 + fr;
                const f32x4 cs = *(const f32x4*)(ROPE + (size_t)row * 64 + d0) * sc, sn = *(const f32x4*)(ROPE + (size_t)row * 64 + 32 + d0) * sc;
                const f32x4 a0 = acc[ai][bj][m][0], a1 = acc[ai][bj][m][1];
                const f32x4 o1 = a0 * cs - a1 * sn, o2 = a1 * cs + a0 * sn;
                bf16_t* dst = base + (size_t)row * ld + 64 * hdl + d0;
                *(u32x2*)dst = (u32x2){pkbf(o1[0], o1[1]), pkbf(o1[2], o1[3])};
                *(u32x2*)(dst + 32) = (u32x2){pkbf(o2[0], o2[1]), pkbf(o2[2], o2[3])};
                asm volatile("" ::: "memory");
            }
    }
    __device__ __forceinline__ void operator()(const f32x4 (&acc)[2][2][4][2], const Unit& u, int wr, int wc, int fr, int fq) const {
        asm volatile("" : "+v"(fr), "+v"(fq));
        const int pn = u.pn;
        if (pn == 0 || pn == 2) {
            bf16_t* O = (pn == 0 ? U : GRG);
#pragma unroll
            for (int ai = 0; ai < 2; ++ai)
#pragma unroll
                for (int m = 0; m < 4; ++m) { bf16_t* rp = O + (size_t)(u.pm * 256 + ai * 128 + wr * 64 + m * 16 + fr) * 256 + wc * 32 + 4 * fq;
#pragma unroll
                    for (int bj = 0; bj < 2; ++bj)
#pragma unroll
                        for (int n = 0; n < 2; ++n) { const f32x4 v = acc[ai][bj][m][n]; *(u32x2*)(rp + bj * 128 + n * 16) = (u32x2){pkbf(v[0], v[1]), pkbf(v[2], v[3])}; }
                    asm volatile("" ::: "memory"); }
        } else if (pn == 1) {
#pragma unroll
            for (int ai = 0; ai < 2; ++ai)
#pragma unroll
                for (int m = 0; m < 4; ++m) { float* rp = XRG + (size_t)(u.pm * 256 + ai * 128 + wr * 64 + m * 16 + fr) * 256 + wc * 32 + 4 * fq;
#pragma unroll
                    for (int bj = 0; bj < 2; ++bj)
#pragma unroll
                        for (int n = 0; n < 2; ++n) *(f32x4*)(rp + bj * 128 + n * 16) = acc[ai][bj][m][n];
                    asm volatile("" ::: "memory"); }
        } else if (pn == 3 || pn == 4) {
            rope_half(acc, 0, u, wr, wc, fr, fq, Q + 256 * (pn - 3), 512, QSCALE); rope_half(acc, 1, u, wr, wc, fr, fq, Q + 256 * (pn - 3) + 128, 512, QSCALE);
        } else if (pn == 6 || pn == 7) {
            rope_half(acc, 0, u, wr, wc, fr, fq, QI + 256 * (pn - 6), 512, 1.0f); rope_half(acc, 1, u, wr, wc, fr, fq, QI + 256 * (pn - 6) + 128, 512, 1.0f);
        } else if (pn == 5) {
            rope_half(acc, 0, u, wr, wc, fr, fq, KB, 128, 1.0f);
            const int g = wc >> 1;
#pragma unroll
            for (int ai = 0; ai < 2; ++ai)
#pragma unroll
                for (int m = 0; m < 4; ++m) { const int row = u.pm * 256 + ai * 128 + wr * 64 + m * 16 + fr, b = row >> 11, t = row & 2047;
#pragma unroll
                    for (int n = 0; n < 2; ++n) { const f32x4 v = acc[ai][1][m][n];
#pragma unroll
                        for (int i = 0; i < 4; ++i) { const int d = 32 * (wc & 1) + 16 * n + 4 * fq + i; VT[((size_t)(b * 2 + g) * 64 + d) * 2048 + t] = (bf16_t)(pkbf(v[i], 0.f) & 0xffffu); } }
                    asm volatile("" ::: "memory"); }
        } else {
            if (wc < 2) rope_half(acc, 0, u, wr, wc, fr, fq, KI, 64, 1.0f);
            if (wc == 0 && fq < 2) {
#pragma unroll
                for (int ai = 0; ai < 2; ++ai)
#pragma unroll
                    for (int m = 0; m < 4; ++m) *(f32x4*)(WI + (size_t)(u.pm * 256 + ai * 128 + wr * 64 + m * 16 + fr) * 8 + 4 * fq) = acc[ai][1][m][0];
            }
        }
    }
};
struct EpiResid {
    static constexpr bool PERM = false, AFTER_DRAIN = false;
    float* H;
    __device__ __forceinline__ void operator()(const f32x4 (&acc)[2][2][4][2], const Unit& u, int wr, int wc, int fr, int fq) const {
        asm volatile("" : "+v"(fr), "+v"(fq));
#pragma unroll
        for (int ai = 0; ai < 2; ++ai)
#pragma unroll
            for (int m = 0; m < 4; ++m) { float* rp = H + (size_t)(u.pm * 256 + ai * 128 + wr * 64 + m * 16 + fr) * D + u.pn * 256 + wc * 32 + 4 * fq;
#pragma unroll
                for (int bj = 0; bj < 2; ++bj)
#pragma unroll
                    for (int n = 0; n < 2; ++n) { f32x4* p = (f32x4*)(rp + bj * 128 + n * 16); *p = *p * ALPHA + acc[ai][bj][m][n]; }
                asm volatile("" ::: "memory"); }
    }
};
struct EpiStoreBf16 {
    static constexpr bool PERM = false, AFTER_DRAIN = false;
    bf16_t* O; int ldc;
    __device__ __forceinline__ void operator()(const f32x4 (&acc)[2][2][4][2], const Unit& u, int wr, int wc, int fr, int fq) const {
        asm volatile("" : "+v"(fr), "+v"(fq));
#pragma unroll
        for (int ai = 0; ai < 2; ++ai)
#pragma unroll
            for (int m = 0; m < 4; ++m) { bf16_t* rp = O + (size_t)(u.pm * 256 + ai * 128 + wr * 64 + m * 16 + fr) * ldc + u.pn * 256 + wc * 32 + 4 * fq;
#pragma unroll
                for (int bj = 0; bj < 2; ++bj)
#pragma unroll
                    for (int n = 0; n < 2; ++n) { const f32x4 v = acc[ai][bj][m][n]; *(u32x2*)(rp + bj * 128 + n * 16) = (u32x2){pkbf(v[0], v[1]), pkbf(v[2], v[3])}; } }
    }
};
struct EpiSwiglu {
    static constexpr bool PERM = false, AFTER_DRAIN = false;
    bf16_t* ACT;
    __device__ __forceinline__ void operator()(const f32x4 (&acc)[2][2][4][2], const Unit& u, int wr, int wc, int fr, int fq) const {
        asm volatile("" : "+v"(fr), "+v"(fq));
#pragma unroll
        for (int ai = 0; ai < 2; ++ai)
#pragma unroll
            for (int m = 0; m < 4; ++m) { bf16_t* rp = ACT + (size_t)(u.pm * 256 + ai * 128 + wr * 64 + m * 16 + fr) * DFF + u.pn * 128 + wc * 32 + 4 * fq;
#pragma unroll
                for (int n = 0; n < 2; ++n) { const f32x4 g = acc[ai][0][m][n], uu = acc[ai][1][m][n]; f32x4 o;
#pragma unroll
                    for (int i = 0; i < 4; ++i) o[i] = g[i] * sigmoidf_(g[i]) * uu[i];
                    *(u32x2*)(rp + n * 16) = (u32x2){pkbf(o[0], o[1]), pkbf(o[2], o[3])}; } }
    }
};
struct EpiPle {
    static constexpr bool PERM = false, AFTER_DRAIN = false;
    bf16_t* PP;
    __device__ __forceinline__ void operator()(const f32x4 (&acc)[2][2][4][2], const Unit& u, int wr, int wc, int fr, int fq) const {
        asm volatile("" : "+v"(fr), "+v"(fq));
#pragma unroll
        for (int ai = 0; ai < 2; ++ai)
#pragma unroll
            for (int m = 0; m < 4; ++m) { bf16_t* rp = PP + (size_t)(u.pm * 256 + ai * 128 + wr * 64 + m * 16 + fr) * D + u.pn * 256 + wc * 32 + 4 * fq;
#pragma unroll
                for (int bj = 0; bj < 2; ++bj)
#pragma unroll
                    for (int n = 0; n < 2; ++n) { const f32x4 v = acc[ai][bj][m][n]; u32x2* p = (u32x2*)(rp + bj * 128 + n * 16); const u32x2 w = *p;
                        *p = (u32x2){pkbf(sigmoidf_(v[0]) * bflo(w[0]), sigmoidf_(v[1]) * bfhi(w[0])), pkbf(sigmoidf_(v[2]) * bflo(w[1]), sigmoidf_(v[3]) * bfhi(w[1]))}; }
                asm volatile("" ::: "memory"); }
    }
};
struct EpiDown {
    static constexpr bool PERM = false, AFTER_DRAIN = false;
    float* H; const bf16_t* PP;
    __device__ __forceinline__ void operator()(const f32x4 (&acc)[2][2][4][2], const Unit& u, int wr, int wc, int fr, int fq) const {
        asm volatile("" : "+v"(fr), "+v"(fq));
#pragma unroll
        for (int ai = 0; ai < 2; ++ai)
#pragma unroll
            for (int m = 0; m < 4; ++m) { const size_t off = (size_t)(u.pm * 256 + ai * 128 + wr * 64 + m * 16 + fr) * D + u.pn * 256 + wc * 32 + 4 * fq;
#pragma unroll
                for (int bj = 0; bj < 2; ++bj)
#pragma unroll
                    for (int n = 0; n < 2; ++n) { f32x4* p = (f32x4*)(H + off + bj * 128 + n * 16); const u32x2 w = *(const u32x2*)(PP + off + bj * 128 + n * 16);
                        const f32x4 pl = {bflo(w[0]), bfhi(w[0]), bflo(w[1]), bfhi(w[1])}; *p = *p * ALPHA + acc[ai][bj][m][n] + pl; }
                asm volatile("" ::: "memory"); }
    }
};

struct Args { const void* in[32]; float* out; unsigned char* ws; int ph_lo, ph_hi; };
typedef const __attribute__((address_space(4))) Args* KArgs;
struct Ctx {
    KArgs a; unsigned char* ws; LAS unsigned char* lds; unsigned char* ldsg;
    int tid, lane, wave, bid, G;
};
#define INF_(i, T) ((const T*)c.a->in[i])

__device__ __forceinline__ int colmap(int kind, int pos) {
    if (kind == 0) return pos;
    const int tile = pos >> 8, p = pos & 255, bj = p >> 7, ph = p & 127;
    if (kind == 2) return (bj ? DFF : 0) + 128 * tile + ph;
    const int wc = ph >> 5, n = (ph >> 4) & 1, fq = (ph >> 2) & 3, i = ph & 3;
    const int rc = 64 * (wc >> 1) + 32 * n + 16 * (wc & 1) + 4 * fq + i;
    if (tile <= 2) return pos;
    if (tile <= 4) return 768 + 256 * (tile - 3) + 128 * bj + rc;
    if (tile == 5) return bj == 0 ? 1280 + rc : 1408 + ph;
    if (tile <= 7) return 1536 + 256 * (tile - 6) + 128 * bj + rc;
    return bj == 0 ? (rc < 64 ? 2048 + rc : -1) : (ph < 8 ? 2112 + ph : -1);
}
__device__ __forceinline__ void transpose_item(const float* W, int K, int N, bf16_t* WT, int kind, LAS float* scr, int item, int nblk, int lane) {
    const int kb = item / nblk, nb = item % nblk, k0 = 64 * kb, n0 = 32 * nb;
    const int col = colmap(kind, n0 + (lane & 31));
#pragma unroll 8
    for (int i = 0; i < 32; ++i) { const int kk = 2 * i + (lane >> 5); scr[kk * 33 + (lane & 31)] = col >= 0 ? W[(size_t)(k0 + kk) * N + col] : 0.f; }
    asm volatile("s_waitcnt lgkmcnt(0)" ::: "memory");
    const int cc = lane & 7;
#pragma unroll
    for (int j = 0; j < 4; ++j) { const int n = (lane >> 3) + 8 * j; const LAS float* s = scr + (8 * cc) * 33 + n;
        u32x4 o; o.x = pkbf(s[0 * 33], s[1 * 33]); o.y = pkbf(s[2 * 33], s[3 * 33]); o.z = pkbf(s[4 * 33], s[5 * 33]); o.w = pkbf(s[6 * 33], s[7 * 33]);
        *(u32x4*)(WT + (size_t)(n0 + n) * K + k0 + 8 * cc) = o; }
    asm volatile("s_waitcnt lgkmcnt(0)" ::: "memory");
}
__device__ __forceinline__ void ln_row(const float* xrow, const float* g, const float* b, float* orow, bf16_t* brow, int lane) {
    const f32x4* xr = (const f32x4*)xrow + lane;
    f32x4 v[4]; float s = 0.f;
#pragma unroll
    for (int j = 0; j < 4; ++j) { v[j] = xr[64 * j]; s += (v[j][0] + v[j][1]) + (v[j][2] + v[j][3]); }
    const float mean = wave_sum(s) * (1.f / D); float s2 = 0.f;
#pragma unroll
    for (int j = 0; j < 4; ++j) { v[j] = v[j] - mean; s2 += (v[j][0] * v[j][0] + v[j][1] * v[j][1]) + (v[j][2] * v[j][2] + v[j][3] * v[j][3]); }
    const float rstd = 1.f / sqrtf(wave_sum(s2) * (1.f / D) + LN_EPS);
#pragma unroll
    for (int j = 0; j < 4; ++j) { const f32x4 gg = ((const f32x4*)g)[lane + 64 * j], bb = ((const f32x4*)b)[lane + 64 * j]; const f32x4 o = v[j] * rstd * gg + bb;
        ((f32x4*)orow)[lane + 64 * j] = o; ((u32x2*)brow)[lane + 64 * j] = (u32x2){pkbf(o[0], o[1]), pkbf(o[2], o[3])}; }
}
__device__ __forceinline__ void ln_pass(const Ctx& c, float* H, const float* g, const float* b, bf16_t* HN) {
    const int gw = c.bid * NWAVES + c.wave, NGW = c.G * NWAVES;
    for (int m = gw; m < M; m += NGW) ln_row(H + (size_t)m * D, g, b, H + (size_t)m * D, HN + (size_t)m * D, c.lane);
}

__device__ __forceinline__ void prologue(const Ctx& c) {
    const int gw = c.bid * NWAVES + c.wave, NGW = c.G * NWAVES;
    const int gt = c.bid * NTHREADS + c.tid, NGT = c.G * NTHREADS;
    {
        LAS float* scr = (LAS float*)(c.lds + c.wave * 16384);
        constexpr int I_IN = 16 * (N_INP / 32), I_OUT = 16 * 32, I_UP = 16 * (NUP / 32), I_DOWN = (DFF / 64) * 32, I_GATE = 16 * 32, I_PP = 4 * 32, I_GLU = 4 * 8;
        constexpr int I_LAYER = I_IN + I_OUT + I_UP + I_DOWN + I_GATE + I_PP + I_GLU;
        for (int it = gw; it < DEPTH * I_LAYER; it += NGW) {
            const int L = it / I_LAYER; int r = it % I_LAYER; unsigned char* wl = c.ws + WS_W + (size_t)L * W_LAYER;
            if (r < I_IN) { transpose_item(INF_(5, float) + (size_t)L * D * N_IN, D, N_IN, (bf16_t*)(wl + OW_IN), 1, scr, r, N_INP / 32, c.lane); continue; } r -= I_IN;
            if (r < I_OUT) { transpose_item(INF_(23, float) + (size_t)L * D * D, D, D, (bf16_t*)(wl + OW_OUT), 0, scr, r, 32, c.lane); continue; } r -= I_OUT;
            if (r < I_UP) { transpose_item(INF_(26, float) + (size_t)L * D * NUP, D, NUP, (bf16_t*)(wl + OW_UP), 2, scr, r, NUP / 32, c.lane); continue; } r -= I_UP;
            if (r < I_DOWN) { transpose_item(INF_(27, float) + (size_t)L * DFF * D, DFF, D, (bf16_t*)(wl + OW_DOWN), 0, scr, r, 32, c.lane); continue; } r -= I_DOWN;
            if (r < I_GATE) { transpose_item(INF_(28, float) + (size_t)L * D * D, D, D, (bf16_t*)(wl + OW_GATE), 0, scr, r, 32, c.lane); continue; } r -= I_GATE;
            if (r < I_PP) { transpose_item(INF_(29, float) + (size_t)L * 256 * D, 256, D, (bf16_t*)(wl + OW_PPROJ), 0, scr, r, 32, c.lane); continue; } r -= I_PP;
            transpose_item(INF_(14, float) + (size_t)L * 256 * 256, 256, 256, (bf16_t*)(wl + OW_GLU), 0, scr, r, 8, c.lane);
        }
    }
    {
        float* ROPE = (float*)(c.ws + WS_ROPE); const int* pos = INF_(2, int);
        for (int e = gt; e < M * 32; e += NGT) { const int m = e >> 5, i = e & 31;
            const float inv = (float)pow(10000.0, -(double)i / 32.0); const float ang = (float)pos[m] * inv;
            ROPE[(size_t)m * 64 + i] = (float)cos((double)ang); ROPE[(size_t)m * 64 + 32 + i] = (float)sin((double)ang); }
    }
    {
        const float* x = INF_(0, float); float* H = c.a->out; bf16_t* HN = (bf16_t*)(c.ws + WS_HN);
        for (int m = gw; m < M; m += NGW) ln_row(x + (size_t)m * D, INF_(3, float), INF_(4, float), H + (size_t)m * D, HN + (size_t)m * D, c.lane);
    }
    for (int e = gt; e < DEPTH * 1024; e += NGT) {
        const int L = e >> 10, gp = e & 1023, g = gp >> 6, p = gp & 63; unsigned char* tb = c.ws + WS_TAB + (size_t)L * TAB_LAYER;
        const double lr = INF_(6, float)[L * 1024 + gp], li = INF_(7, float)[L * 1024 + gp], st = exp((double)INF_(8, float)[L * 16 + g]);
        const double mag = exp(lr * st), ar = mag * cos(li * st), ai = mag * sin(li * st);
        const double mag64 = exp(64.0 * lr * st), ar64 = mag64 * cos(64.0 * li * st), ai64 = mag64 * sin(64.0 * li * st);
        ((f32x4*)(tb + TAB_LAM))[gp] = (f32x4){(float)ar, (float)ai, (float)ar64, (float)ai64};
        const double den = lr * lr + li * li, nr = ar - 1.0, ni = ai, cr = (nr * lr + ni * li) / den, ci = (ni * lr - nr * li) / den;
        const float* bre = INF_(9, float) + ((size_t)L * 1024 + gp) * 16; const float* bim = INF_(10, float) + ((size_t)L * 1024 + gp) * 16;
        float* BBR = (float*)(tb + TAB_BBR); float* BBI = (float*)(tb + TAB_BBI);
        for (int q = 0; q < 16; ++q) { const double br = bre[q], bi = bim[q]; BBR[(g * 16 + q) * 64 + p] = (float)(cr * br - ci * bi); BBI[(g * 16 + q) * 64 + p] = (float)(cr * bi + ci * br); }
        const float* cre = INF_(11, float) + (size_t)L * 16384 + g * 1024; const float* cim = INF_(12, float) + (size_t)L * 16384 + g * 1024;
        unsigned* CM = (unsigned*)(tb + TAB_CM);
        for (int co = 0; co < 16; ++co) CM[(g * 16 + co) * 64 + p] = pkbf(cre[co * 64 + p], -cim[co * 64 + p]);
    }
    for (int e = gt; e < DEPTH * 256; e += NGT) { const int L = e >> 8, j = e & 255; const float lam = INF_(22, float)[e];
        ((float*)(c.ws + WS_TAB + (size_t)L * TAB_LAYER + TAB_SP))[j] = (float)log1p(exp(-(double)lam)); }
    {
        const f32x4* p4 = (const f32x4*)INF_(1, float); u32x4* pb = (u32x4*)(c.ws + WS_PB);
        for (int e = gt; e < DEPTH * M * 256 / 8; e += NGT) { const f32x4 a = p4[2 * e], b = p4[2 * e + 1]; pb[e] = (u32x4){pkbf(a[0], a[1]), pkbf(a[2], a[3]), pkbf(b[0], b[1]), pkbf(b[2], b[3])}; }
    }
}

struct S5State { float bbr[2][16], bbi[2][16], ar[2], ai[2], xr[2], xi[2]; };
__device__ __forceinline__ void s5_load_params(const Ctx& c, int L, S5State& S) {
    const unsigned char* tb = c.ws + WS_TAB + (size_t)L * TAB_LAYER;
    unsigned lo_ = (unsigned)c.lane * 4u; asm volatile("" : "+v"(lo_));
#pragma unroll
    for (int s = 0; s < 2; ++s) { const int g = 2 * c.wave + s; const f32x4 lm = ((const f32x4*)(tb + TAB_LAM))[g * 64 + c.lane]; S.ar[s] = lm[0]; S.ai[s] = lm[1];
        const unsigned char* pr = tb + TAB_BBR + (size_t)g * 4096 + lo_; const unsigned char* pi = tb + TAB_BBI + (size_t)g * 4096 + lo_;
#pragma unroll
        for (int q = 0; q < 16; ++q) { S.bbr[s][q] = *(const float*)(pr + q * 256); S.bbi[s][q] = *(const float*)(pi + q * 256); } }
}
__device__ __forceinline__ void s5_load_u(const Ctx& c, int chunk) {
    const u32x4* src = (const u32x4*)(c.ws + WS_U + (size_t)chunk * 64 * 512);
#pragma unroll
    for (int i = 0; i < 4; ++i) *(LAS u32x4*)(c.lds + (c.tid + i * 512) * 16) = src[c.tid + i * 512];
}
__device__ __forceinline__ void s5_step(const Ctx& c, S5State& S, int t) {
#pragma unroll
    for (int s = 0; s < 2; ++s) { const int g = 2 * c.wave + s;
        const u32x4 ua = *(const LAS u32x4*)(c.lds + t * 512 + g * 32), ub = *(const LAS u32x4*)(c.lds + t * 512 + g * 32 + 16);
        float uu[16];
#pragma unroll
        for (int q = 0; q < 4; ++q) { uu[2 * q] = bflo(ua[q]); uu[2 * q + 1] = bfhi(ua[q]); uu[8 + 2 * q] = bflo(ub[q]); uu[8 + 2 * q + 1] = bfhi(ub[q]); }
        float br = 0.f, bi = 0.f;
#pragma unroll
        for (int q = 0; q < 16; ++q) { br = fmaf(S.bbr[s][q], uu[q], br); bi = fmaf(S.bbi[s][q], uu[q], bi); }
        const float nr = S.ar[s] * S.xr[s] - S.ai[s] * S.xi[s] + br, ni = S.ar[s] * S.xi[s] + S.ai[s] * S.xr[s] + bi;
        S.xr[s] = nr; S.xi[s] = ni; }
}
__device__ __forceinline__ void s5_pass1_unit(const Ctx& c, int L, int chunk) {
    S5State S; s5_load_params(c, L, S); s5_load_u(c, chunk);
    S.xr[0] = S.xi[0] = S.xr[1] = S.xi[1] = 0.f;
    __syncthreads();
#pragma unroll 1
    for (int t = 0; t < 64; ++t) s5_step(c, S, t);
    f32x2_t* out = (f32x2_t*)(c.ws + WS_S5S) + (size_t)chunk * 1024;
#pragma unroll
    for (int s = 0; s < 2; ++s) out[(2 * c.wave + s) * 64 + c.lane] = (f32x2_t){S.xr[s], S.xi[s]};
    __syncthreads();
}
constexpr int S5_YP = 32768, S5_YP_STRIDE = 264, S5_XS = S5_YP + 64 * S5_YP_STRIDE * 2;
static_assert(S5_XS + 8 * 8192 <= LDS_BYTES, "s5 lds");
__device__ __forceinline__ void s5_pass2_unit(const Ctx& c, int L, int chunk) {
    const unsigned char* tb = c.ws + WS_TAB + (size_t)L * TAB_LAYER;
    S5State S; s5_load_params(c, L, S); s5_load_u(c, chunk);
    int lane = c.lane; asm volatile("" : "+v"(lane));
    const int w = c.wave, fr = lane & 15, fq = lane >> 4;
    {
        const int cs = chunk & 31; const f32x2_t* sp = (const f32x2_t*)(c.ws + WS_S5S) + (size_t)(chunk - cs) * 1024;
#pragma unroll
        for (int s = 0; s < 2; ++s) { const int gp = (2 * w + s) * 64 + lane; const f32x4 lm = ((const f32x4*)(tb + TAB_LAM))[gp]; float xr = 0.f, xi = 0.f;
            for (int k = 0; k < cs; ++k) { const f32x2_t sv = sp[(size_t)k * 1024 + gp]; const float nr = lm[2] * xr - lm[3] * xi + sv[0], ni = lm[2] * xi + lm[3] * xr + sv[1]; xr = nr; xi = ni; }
            S.xr[s] = xr; S.xi[s] = xi; }
    }
    const unsigned char* cmp = tb + TAB_CM + ((size_t)((2 * w) * 16 + fr) * 128 + 8 * fq) * 2;
    const float* dsk = INF_(13, float) + L * 256;
    float dk[2]; dk[0] = dsk[(2 * w) * 16 + fr]; dk[1] = dsk[(2 * w + 1) * 16 + fr];
    __syncthreads();
    LAS unsigned char* xs = c.lds + S5_XS + w * 8192;
#pragma unroll 1
    for (int sb = 0; sb < 4; ++sb) {
#pragma unroll 1
        for (int tt = 0; tt < 16; ++tt) {
            s5_step(c, S, sb * 16 + tt);
#pragma unroll
            for (int s = 0; s < 2; ++s) *(LAS unsigned*)(xs + (tt * 2 + s) * 256 + lane * 4) = pkbf(S.xr[s], S.xi[s]);
        }
#pragma unroll
        for (int s = 0; s < 2; ++s) {
            f32x4 acc = {0.f, 0.f, 0.f, 0.f};
#pragma unroll
            for (int ks = 0; ks < 4; ++ks) { const bf16x8 af = *(const LAS bf16x8*)(xs + (fr * 2 + s) * 256 + (32 * ks + 8 * fq) * 2);
                const bf16x8 cmf = *(const bf16x8*)(cmp + s * 4096 + ks * 64);
                acc = __builtin_amdgcn_mfma_f32_16x16x32_bf16(af, cmf, acc, 0, 0, 0); }
            const int g = 2 * w + s;
#pragma unroll
            for (int i = 0; i < 4; ++i) { const int t = sb * 16 + 4 * fq + i; const float uv = bf2f(*(const LAS unsigned short*)(c.lds + t * 512 + (g * 16 + fr) * 2));
                const float y = gelu_tanh(acc[i] + dk[s] * uv);
                *(LAS unsigned short*)(c.lds + S5_YP + (t * S5_YP_STRIDE + g * 16 + fr) * 2) = (unsigned short)(pkbf(y, 0.f) & 0xffffu); }
        }
    }
    __syncthreads();
    {
        const bf16_t* GT = (const bf16_t*)(c.ws + WS_W + (size_t)L * W_LAYER + OW_GLU);
        f32x4 z[4][2];
#pragma unroll
        for (int tb_ = 0; tb_ < 4; ++tb_) { z[tb_][0] = (f32x4){0.f, 0.f, 0.f, 0.f}; z[tb_][1] = (f32x4){0.f, 0.f, 0.f, 0.f}; }
#pragma unroll 1
        for (int ks = 0; ks < 8; ++ks) {
            bf16x8 bfr[2];
#pragma unroll
            for (int nt = 0; nt < 2; ++nt) bfr[nt] = *(const bf16x8*)(GT + (size_t)(32 * w + 16 * nt + fr) * 256 + 32 * ks + 8 * fq);
#pragma unroll
            for (int tb_ = 0; tb_ < 4; ++tb_) { const bf16x8 af = *(const LAS bf16x8*)(c.lds + S5_YP + ((16 * tb_ + fr) * S5_YP_STRIDE + 32 * ks + 8 * fq) * 2);
#pragma unroll
                for (int nt = 0; nt < 2; ++nt) z[tb_][nt] = __builtin_amdgcn_mfma_f32_16x16x32_bf16(af, bfr[nt], z[tb_][nt], 0, 0, 0); }
        }
        const float* bg = INF_(15, float) + L * 256; bf16_t* Y = (bf16_t*)(c.ws + WS_Y);
#pragma unroll
        for (int nt = 0; nt < 2; ++nt) { const int n = 32 * w + 16 * nt + fr; const float bgn = bg[n];
#pragma unroll
            for (int tb_ = 0; tb_ < 4; ++tb_)
#pragma unroll
                for (int i = 0; i < 4; ++i) { const int t = 16 * tb_ + 4 * fq + i; const float yp = bf2f(*(const LAS unsigned short*)(c.lds + S5_YP + (t * S5_YP_STRIDE + n) * 2));
                    Y[(size_t)(chunk * 64 + t) * D + n] = (bf16_t)(pkbf(yp * sigmoidf_(z[tb_][nt][i] + bgn), 0.f) & 0xffffu); } }
    }
    __syncthreads();
}

__device__ __forceinline__ void rg_pass1_unit(const Ctx& c, int L, int u) {
    int tid_ = c.tid; asm volatile("" : "+v"(tid_));
    const int j = tid_ & 255, half = tid_ >> 8, m0 = u * 64, tl0 = half * 32;
    const float* X = (const float*)(c.ws + WS_XRG);
    const float* cw = INF_(16, float) + L * 1024; const float cb = INF_(17, float)[L * 256 + j];
    const float w0 = cw[j], w1 = cw[256 + j], w2 = cw[512 + j], w3 = cw[768 + j];
    LAS float* xc = (LAS float*)c.lds;
    {
        const int mm = m0 + tl0; const bool seq_start = ((mm & 2047) == 0);
        float x0 = seq_start ? 0.f : X[(size_t)(mm - 3) * 256 + j], x1 = seq_start ? 0.f : X[(size_t)(mm - 2) * 256 + j], x2 = seq_start ? 0.f : X[(size_t)(mm - 1) * 256 + j];
        for (int t = 0; t < 32; ++t) { const float x3 = X[(size_t)(mm + t) * 256 + j]; xc[(tl0 + t) * 256 + j] = cb + w0 * x0 + w1 * x1 + w2 * x2 + w3 * x3; x0 = x1; x1 = x2; x2 = x3; }
    }
    const int hb = j >> 5, jj = j & 31;
    float wa[32], wx[32];
    { const float* WA = INF_(18, float) + (size_t)L * 8192 + hb * 1024; const float* WX = INF_(20, float) + (size_t)L * 8192 + hb * 1024;
#pragma unroll
      for (int i = 0; i < 32; ++i) { wa[i] = WA[i * 32 + jj]; wx[i] = WX[i * 32 + jj]; } }
    const float ba = INF_(19, float)[L * 256 + j], bx = INF_(21, float)[L * 256 + j];
    const float sp = ((const float*)(c.ws + WS_TAB + (size_t)L * TAB_LAYER + TAB_SP))[j];
    float* RA = (float*)(c.ws + WS_RA); float* RB = (float*)(c.ws + WS_RB);
    __syncthreads();
    for (int t = 0; t < 32; ++t) { const int tl = tl0 + t; float ra = ba, rx = bx;
#pragma unroll
        for (int i4 = 0; i4 < 8; ++i4) { const f32x4 xv = *(const LAS f32x4*)(xc + tl * 256 + hb * 32 + 4 * i4);
#pragma unroll
            for (int q = 0; q < 4; ++q) { ra = fmaf(xv[q], wa[4 * i4 + q], ra); rx = fmaf(xv[q], wx[4 * i4 + q], rx); } }
        const float r = sigmoidf_(ra), ig = sigmoidf_(rx), xcv = xc[tl * 256 + j];
        const float log_a = -8.0f * r * sp, a = expf(log_a), mult = sqrtf(-expm1f(2.0f * log_a));
        RA[(size_t)(m0 + tl) * 256 + j] = a; RB[(size_t)(m0 + tl) * 256 + j] = mult * (ig * xcv); }
    __syncthreads();
}
__device__ __forceinline__ void rg_scan_unit(const Ctx& c, int u) {
    int tid_ = c.tid; asm volatile("" : "+v"(tid_));
    const int b = u >> 3, hb = u & 7, jj = tid_ & 31, seg = tid_ >> 5, j = hb * 32 + jj;
    const float* RA = (const float*)(c.ws + WS_RA) + (size_t)(b * 2048 + seg * 128) * 256 + j; const float* RB = (const float*)(c.ws + WS_RB) + (size_t)(b * 2048 + seg * 128) * 256 + j;
    float A = 1.f, Hh = 0.f;
#pragma unroll 8
    for (int t = 0; t < 128; ++t) { const float a = RA[(size_t)t * 256], bv = RB[(size_t)t * 256]; Hh = fmaf(a, Hh, bv); A *= a; }
    LAS float* ex = (LAS float*)c.lds;
    ex[(seg * 32 + jj) * 2] = A; ex[(seg * 32 + jj) * 2 + 1] = Hh;
    __syncthreads();
    float h = 0.f;
    for (int s = 0; s < seg; ++s) h = fmaf(ex[(s * 32 + jj) * 2], h, ex[(s * 32 + jj) * 2 + 1]);
    const bf16_t* G = (const bf16_t*)(c.ws + WS_GRG) + (size_t)(b * 2048 + seg * 128) * 256 + j; bf16_t* Y = (bf16_t*)(c.ws + WS_Y) + (size_t)(b * 2048 + seg * 128) * D + 256 + j;
#pragma unroll 8
    for (int t = 0; t < 128; ++t) { const float a = RA[(size_t)t * 256], bv = RB[(size_t)t * 256]; h = fmaf(a, h, bv);
        Y[(size_t)t * D] = (bf16_t)(pkbf(h * gelu_tanh(bf2f(G[(size_t)t * 256])), 0.f) & 0xffffu); }
    __syncthreads();
}

constexpr int IDX_STRIDE = 2064;
static_assert(16 * IDX_STRIDE * 4 <= LDS_BYTES, "indexer lds");
template <int NR>
__device__ __forceinline__ void select_row(const LAS float* row, int nk, int lane, unsigned* selrow) {
    float v[NR];
#pragma unroll
    for (int r = 0; r < NR; ++r) { const int idx = 64 * r + lane; v[r] = idx < nk ? row[idx] : -INFINITY; }
    float mx = -INFINITY, mn = INFINITY;
#pragma unroll
    for (int r = 0; r < NR; ++r) { mx = fmaxf(mx, v[r]); mn = fminf(mn, v[r] == -INFINITY ? INFINITY : v[r]); }
    mx = wave_max(mx); mn = wave_min(mn);
    float lo = mn, hi = mx, thr = 0.f; bool tie = false; int cgt = 0;
    {
        int ch = 0;
#pragma unroll
        for (int r = 0; r < NR; ++r) ch += (v[r] >= hi) ? 1 : 0;
        ch = wave_sum_i(ch);
        if (ch >= 256) { tie = true; lo = hi; cgt = 0; }
        else {
            cgt = ch;
            for (;;) {
                const float mid = lo + 0.5f * (hi - lo);
                if (!(mid > lo) || !(mid < hi)) { tie = true; break; }
                int cm = 0;
#pragma unroll
                for (int r = 0; r < NR; ++r) cm += (v[r] >= mid) ? 1 : 0;
                cm = wave_sum_i(cm);
                if (cm == 256) { thr = mid; break; }
                if (cm > 256) lo = mid; else { hi = mid; cgt = cm; }
            }
        }
    }
    unsigned long long mine = 0ull;
    if (!tie) {
#pragma unroll
        for (int r = 0; r < NR; ++r) { const unsigned long long mk = __ballot(v[r] >= thr); if (lane == r) mine = mk; }
    } else {
        int need = 256 - cgt, base = 0;
#pragma unroll
        for (int r = 0; r < NR; ++r) { const unsigned long long tm = __ballot(v[r] == lo); const int rank = base + __builtin_popcountll(tm & ((1ull << lane) - 1ull));
            const unsigned long long mk = __ballot(v[r] > lo || (v[r] == lo && rank < need)); base += __builtin_popcountll(tm); if (lane == r) mine = mk; }
    }
    if (lane < 32) *(unsigned long long*)(selrow + 2 * lane) = mine;
}
__device__ __forceinline__ void idx_unit(const Ctx& c, int b, int qt) {
    int lane = c.lane; asm volatile("" : "+v"(lane));
    const int w = c.wave, fr = lane & 15, fq = lane >> 4, t0 = 16 * qt, nkb = qt + 1, nk = t0 + 16;
    const size_t mb = (size_t)b * 2048;
    const bf16_t* QI = (const bf16_t*)(c.ws + WS_QI); const bf16_t* KI = (const bf16_t*)(c.ws + WS_KI); const float* WI = (const float*)(c.ws + WS_WI);
    bf16x8 af[4][2][2]; float wt[4][8];
#pragma unroll
    for (int G = 0; G < 4; ++G) {
#pragma unroll
        for (int hl = 0; hl < 2; ++hl)
#pragma unroll
            for (int ks = 0; ks < 2; ++ks) af[G][hl][ks] = *(const bf16x8*)(QI + (mb + t0 + 4 * G + (fr >> 2)) * 512 + 64 * (4 * hl + (fr & 3)) + 32 * ks + 8 * fq);
#pragma unroll
        for (int h = 0; h < 8; ++h) wt[G][h] = WI[(mb + t0 + 4 * G + fq) * 8 + h] * IDX_SCALE;
    }
    LAS float* sc = (LAS float*)c.lds;
    for (int kb = w; kb < nkb; kb += 8) {
        bf16x8 bfr[2];
#pragma unroll
        for (int ks = 0; ks < 2; ++ks) bfr[ks] = *(const bf16x8*)(KI + (mb + 16 * kb + fr) * 64 + 32 * ks + 8 * fq);
        const int key = 16 * kb + fr;
#pragma unroll
        for (int G = 0; G < 4; ++G) {
            f32x4 lo = {0.f, 0.f, 0.f, 0.f}, hi = {0.f, 0.f, 0.f, 0.f};
            lo = __builtin_amdgcn_mfma_f32_16x16x32_bf16(af[G][0][0], bfr[0], lo, 0, 0, 0); lo = __builtin_amdgcn_mfma_f32_16x16x32_bf16(af[G][0][1], bfr[1], lo, 0, 0, 0);
            hi = __builtin_amdgcn_mfma_f32_16x16x32_bf16(af[G][1][0], bfr[0], hi, 0, 0, 0); hi = __builtin_amdgcn_mfma_f32_16x16x32_bf16(af[G][1][1], bfr[1], hi, 0, 0, 0);
            float s = 0.f;
#pragma unroll
            for (int i = 0; i < 4; ++i) { s = fmaf(fmaxf(lo[i], 0.f), wt[G][i], s); s = fmaf(fmaxf(hi[i], 0.f), wt[G][4 + i], s); }
            const int q = 4 * G + fq;
            if (key > t0 + q) s = -INFINITY;
            sc[q * IDX_STRIDE + key] = s;
        }
    }
    __syncthreads();
    unsigned* SEL = (unsigned*)(c.ws + WS_SEL);
    const int nr = (nk + 63) >> 6;
#pragma unroll
    for (int qq = 0; qq < 2; ++qq) { const int q = 2 * w + qq; unsigned* selrow = SEL + (mb + t0 + q) * 64; const LAS float* row = sc + q * IDX_STRIDE;
        if (nr <= 8) select_row<8>(row, nk, lane, selrow); else if (nr <= 16) select_row<16>(row, nk, lane, selrow);
        else if (nr <= 24) select_row<24>(row, nk, lane, selrow); else select_row<32>(row, nk, lane, selrow); }
    __syncthreads();
}
__device__ __forceinline__ void maskfill_unit(const Ctx& c, int b, int qt) {
#pragma unroll
    for (int qq = 0; qq < 2; ++qq) { const int t = 16 * qt + 2 * c.wave + qq; unsigned* selrow = (unsigned*)(c.ws + WS_SEL) + ((size_t)b * 2048 + t) * 64;
        if (c.lane < 32) { const int k0 = 64 * c.lane; unsigned long long mk = 0ull; if (k0 + 63 <= t) mk = ~0ull; else if (k0 <= t) mk = (1ull << (t - k0 + 1)) - 1ull;
            *(unsigned long long*)(selrow + 2 * c.lane) = mk; } }
}

__device__ __forceinline__ void attn_unit(const Ctx& c, int b, int g, int qb) {
    int lane = c.lane; asm volatile("" : "+v"(lane));
    int tid = c.tid; asm volatile("" : "+v"(tid));
    const int w = c.wave, r32 = lane & 31, h5 = lane >> 5, head = 4 * g + (w & 3), tq0 = 64 * qb + 32 * (w >> 2), tq = tq0 + r32;
    const size_t mb = (size_t)b * 2048;
    const bf16_t* Q = (const bf16_t*)(c.ws + WS_Q);
    const bf16_t* Kg = (const bf16_t*)(c.ws + WS_KB) + (mb + (tid >> 3)) * 128 + 64 * g + 8 * (tid & 7);
    const bf16_t* Vg = (const bf16_t*)(c.ws + WS_VT) + ((size_t)(b * 2 + g) * 64 + (tid >> 3)) * 2048 + 8 * (tid & 7);
    const unsigned long long* SELq = (const unsigned long long*)((const unsigned*)(c.ws + WS_SEL) + (mb + tq) * 64);
    const int srow = tid >> 3, sch = tid & 7;
    const int kdst = srow * 128 + ((sch ^ ((srow >> 1) & 7)) << 4);
    const int vdst = 8192 + srow * 128 + ((sch ^ ((srow >> 2) & 7)) << 4); const bool vswap = (srow >> 1) & 1;
    const int xk = (r32 >> 1) & 7, xv = (r32 >> 1) & 15;
    int koff[4], voff[8];
#pragma unroll
    for (int ks = 0; ks < 4; ++ks) koff[ks] = r32 * 128 + (((2 * ks + h5) ^ xk) << 4);
#pragma unroll
    for (int s = 0; s < 4; ++s) { voff[2 * s] = 8192 + r32 * 128 + (((4 * s + h5) ^ xv) << 3); voff[2 * s + 1] = 8192 + r32 * 128 + (((4 * s + 2 + h5) ^ xv) << 3); }
    bf16x8 qf[4];
#pragma unroll
    for (int ks = 0; ks < 4; ++ks) qf[ks] = *(const bf16x8*)(Q + (mb + tq) * 512 + 64 * head + 16 * ks + 8 * h5);
    f32x16 o0 = {}, o1 = {}; float mrun = -1e30f, lrun = 0.f;
    const int NT = qb + 1;
    u32x4 kreg = *(const u32x4*)Kg, vreg = *(const u32x4*)Vg; unsigned long long mnext = SELq[0];
    if (vswap) vreg = (u32x4){vreg[2], vreg[3], vreg[0], vreg[1]};
    *(LAS u32x4*)(c.lds + kdst) = kreg; *(LAS u32x4*)(c.lds + vdst) = vreg;
    __syncthreads();
    for (int kt = 0; kt < NT; ++kt) {
        LAS unsigned char* buf = c.lds + (kt & 1) * 16384;
        const unsigned long long mw = mnext;
        if (kt + 1 < NT) { kreg = *(const u32x4*)(Kg + (size_t)(kt + 1) * 64 * 128); vreg = *(const u32x4*)(Vg + (kt + 1) * 64); mnext = SELq[kt + 1]; }
        f32x16 s0 = {}, s1 = {};
#pragma unroll
        for (int ks = 0; ks < 4; ++ks) { const bf16x8 k0 = *(const LAS bf16x8*)(buf + koff[ks]), k1 = *(const LAS bf16x8*)(buf + 4096 + koff[ks]);
            s0 = __builtin_amdgcn_mfma_f32_32x32x16_bf16(k0, qf[ks], s0, 0, 0, 0); s1 = __builtin_amdgcn_mfma_f32_32x32x16_bf16(k1, qf[ks], s1, 0, 0, 0); }
        const unsigned mlo = (unsigned)mw, mhi = (unsigned)(mw >> 32);
        float rmax = -INFINITY;
#pragma unroll
        for (int i = 0; i < 16; ++i) { const int kl = (i & 3) + 8 * (i >> 2) + 4 * h5;
            if (!((mlo >> kl) & 1u)) s0[i] = -INFINITY; if (!((mhi >> kl) & 1u)) s1[i] = -INFINITY; rmax = fmaxf(rmax, fmaxf(s0[i], s1[i])); }
        rmax = xhalf_max(rmax);
        const float mnew = fmaxf(mrun, rmax), alpha = exp2f(mrun - mnew);
        float rs = 0.f;
#pragma unroll
        for (int i = 0; i < 16; ++i) { s0[i] = exp2f(s0[i] - mnew); s1[i] = exp2f(s1[i] - mnew); rs += s0[i] + s1[i]; }
        rs = xhalf_sum(rs);
        lrun = lrun * alpha + rs; mrun = mnew;
#pragma unroll
        for (int i = 0; i < 16; ++i) { o0[i] *= alpha; o1[i] *= alpha; }
#pragma unroll
        for (int s = 0; s < 4; ++s) {
            bf16x8 pf;
            { const int o8 = 8 * (s & 1);
              const u32x4 pw = (s < 2) ? (u32x4){pkbf(s0[o8 + 0], s0[o8 + 1]), pkbf(s0[o8 + 2], s0[o8 + 3]), pkbf(s0[o8 + 4], s0[o8 + 5]), pkbf(s0[o8 + 6], s0[o8 + 7])}
                                       : (u32x4){pkbf(s1[o8 + 0], s1[o8 + 1]), pkbf(s1[o8 + 2], s1[o8 + 3]), pkbf(s1[o8 + 4], s1[o8 + 5]), pkbf(s1[o8 + 6], s1[o8 + 7])};
              pf = __builtin_bit_cast(bf16x8, pw); }
#pragma unroll
            for (int dt = 0; dt < 2; ++dt) {
                const u32x2 va = *(const LAS u32x2*)(buf + dt * 4096 + voff[2 * s]), vb = *(const LAS u32x2*)(buf + dt * 4096 + voff[2 * s + 1]);
                const u32x4 vw = {va[0], va[1], vb[0], vb[1]}; const bf16x8 vf = __builtin_bit_cast(bf16x8, vw);
                if (dt == 0) o0 = __builtin_amdgcn_mfma_f32_32x32x16_bf16(vf, pf, o0, 0, 0, 0); else o1 = __builtin_amdgcn_mfma_f32_32x32x16_bf16(vf, pf, o1, 0, 0, 0);
            }
        }
        if (kt + 1 < NT) { LAS unsigned char* nb = c.lds + ((kt + 1) & 1) * 16384;
            if (vswap) vreg = (u32x4){vreg[2], vreg[3], vreg[0], vreg[1]};
            *(LAS u32x4*)(nb + kdst) = kreg; *(LAS u32x4*)(nb + vdst) = vreg; }
        __syncthreads();
    }
    const float rl = 1.0f / lrun;
    bf16_t* Y = (bf16_t*)(c.ws + WS_Y) + (mb + tq) * D + 512 + 64 * head;
#pragma unroll
    for (int i4 = 0; i4 < 4; ++i4) { const int d = 8 * i4 + 4 * h5;
        *(u32x2*)(Y + d) = (u32x2){pkbf(o0[4 * i4] * rl, o0[4 * i4 + 1] * rl), pkbf(o0[4 * i4 + 2] * rl, o0[4 * i4 + 3] * rl)};
        *(u32x2*)(Y + 32 + d) = (u32x2){pkbf(o1[4 * i4] * rl, o1[4 * i4 + 1] * rl), pkbf(o1[4 * i4 + 2] * rl, o1[4 * i4 + 3] * rl)}; }
}

template <class Epi>
__device__ __forceinline__ void run_gemm(const Ctx& c, const bf16_t* A, const bf16_t* Bt, int N, int K, const Epi& E) {
    asm volatile("" : "+s"(K));
    pg8::Gemm g{A, Bt, M, N, K}; pg8::StaticOrder S; S.init(M, N, c.G, c.bid);
    pg8::gemm_phase<Epi, pg8::StaticOrder, true, true>(c.lds, g, S, E);
}

#ifndef DIS
#define DIS 0
#endif
template <int S>
__device__ __forceinline__ void run_stage(const Ctx& c, int L) {
    if constexpr ((DIS >> S) & 1) return;
    unsigned char* ws = c.ws; unsigned char* wl = ws + WS_W + (size_t)L * W_LAYER; float* H = c.a->out; bf16_t* HN = (bf16_t*)(ws + WS_HN);
    if constexpr (S == 10) { prologue(c); }
    if constexpr (S == 0) {
        EpiProj E{(bf16_t*)(ws + WS_U), (bf16_t*)(ws + WS_GRG), (bf16_t*)(ws + WS_Q), (bf16_t*)(ws + WS_KB), (bf16_t*)(ws + WS_VT), (bf16_t*)(ws + WS_QI), (bf16_t*)(ws + WS_KI),
                  (float*)(ws + WS_XRG), (float*)(ws + WS_WI), (const float*)(ws + WS_ROPE)};
        run_gemm(c, HN, (const bf16_t*)(wl + OW_IN), N_INP, D, E);
    }
    if constexpr (S == 1) {
        for (int u = c.bid; u < 1536; u += c.G) {
            if (u < 896) idx_unit(c, u & 7, 127 - (u >> 3));
            else if (u < 1024) maskfill_unit(c, (u - 896) & 7, (u - 896) >> 3);
            else if (u < 1280) s5_pass1_unit(c, L, u - 1024);
            else rg_pass1_unit(c, L, u - 1280);
        }
    }
    if constexpr (S == 2) {
        for (int u = c.bid; u < 832; u += c.G) {
            if (u < 512) { const int r = u >> 4, inner = u & 15; attn_unit(c, inner >> 1, inner & 1, u < 256 ? 31 - r : r - 16); }
            else if (u < 768) s5_pass2_unit(c, L, u - 512);
            else rg_scan_unit(c, u - 768);
        }
    }
    if constexpr (S == 3) { EpiResid E{H}; run_gemm(c, (const bf16_t*)(ws + WS_Y), (const bf16_t*)(wl + OW_OUT), D, D, E); }
    if constexpr (S == 4) ln_pass(c, H, INF_(24, float) + L * D, INF_(25, float) + L * D, HN);
    if constexpr (S == 5) { EpiStoreBf16 E{(bf16_t*)(ws + WS_Y), D}; run_gemm(c, (const bf16_t*)(ws + WS_PB) + (size_t)L * M * 256, (const bf16_t*)(wl + OW_PPROJ), D, 256, E); }
    if constexpr (S == 6) { EpiSwiglu E{(bf16_t*)(ws + WS_ACT)}; run_gemm(c, HN, (const bf16_t*)(wl + OW_UP), NUP, D, E); }
    if constexpr (S == 7) { EpiPle E{(bf16_t*)(ws + WS_Y)}; run_gemm(c, HN, (const bf16_t*)(wl + OW_GATE), D, D, E); }
    if constexpr (S == 8) { EpiDown E{H, (const bf16_t*)(ws + WS_Y)}; run_gemm(c, (const bf16_t*)(ws + WS_ACT), (const bf16_t*)(wl + OW_DOWN), D, DFF, E); }
    if constexpr (S == 9) ln_pass(c, H, INF_(30, float) + L * D, INF_(31, float) + L * D, HN);
}
constexpr int N_GROUPS = 1 + 8 * DEPTH;
#define GAS __attribute__((address_space(1)))
constexpr size_t WS_CTL = 0, CTL_ZERO_BYTES = 1 * MiB;
constexpr int CW_BAR = 4096;
constexpr int MISC_OFF = 143360;
static_assert(MISC_OFF + 64 <= LDS_BYTES && 16 * IDX_STRIDE * 4 <= MISC_OFF, "lds map");
#define XB_TMO      128
#define XB_XCNT(j)  (256  + 64 * (j))
#define XB_XSUB(j)  (1280 + 64 * (j))
#define XB_XGEN(j)  (2304 + 64 * (j))
#define XB_TOP      3328
#define XB_TOPGEN   3392
#define XCD_BAR_WORDS 3456
#define XB_SPIN_CAP (1u << 18)

__device__ __forceinline__ unsigned xb_ld(unsigned* p)              { return __hip_atomic_load(p, __ATOMIC_RELAXED, __HIP_MEMORY_SCOPE_AGENT); }
__device__ __forceinline__ unsigned xb_add(unsigned* p, unsigned v) { return __hip_atomic_fetch_add(p, v, __ATOMIC_RELAXED, __HIP_MEMORY_SCOPE_AGENT); }
__device__ __forceinline__ unsigned xb_xcc_id() { return (unsigned)__builtin_amdgcn_s_getreg((3 << 11) | 20) & 0xFu; }
#define XB_SPIN(cond, bar) do { unsigned _sp = 0; while (cond) { __builtin_amdgcn_s_sleep(1); \
    if ((++_sp & 255u) == 0u) { if (xb_ld(&(bar)[XB_TMO])) break; if (_sp > XB_SPIN_CAP) { atomicAdd(&(bar)[XB_TMO], 1u); break; } } } } while (0)

struct XcdBarrier {
    unsigned* bar; unsigned x;
    volatile LAS unsigned* st;
};

__device__ __forceinline__ XcdBarrier xcd_barrier_post(unsigned* bar, volatile LAS unsigned* st) {
    XcdBarrier b; b.bar = bar; b.x = xb_xcc_id(); b.st = st;
    if (threadIdx.x == 0) (void)xb_add(&bar[XB_XCNT(b.x)], 1u);
    return b;
}
__device__ __forceinline__ void xcd_barrier_complete(unsigned* bar, unsigned x, unsigned& nloc, unsigned& nx) {
    const unsigned G = gridDim.x * gridDim.y * gridDim.z;
    unsigned sum, cnt, mine, sp = 0u;
    for (;;) {
        sum = 0u; cnt = 0u; mine = 0u;
#pragma unroll
        for (unsigned j = 0; j < 16; ++j) { const unsigned c = xb_ld(&bar[XB_XCNT(j)]); sum += c; cnt += (c > 0u) ? 1u : 0u; mine = (j == x) ? c : mine; }
        if (sum == G) break;
        __builtin_amdgcn_s_sleep(1);
        if ((++sp & 255u) == 0u) { if (xb_ld(&bar[XB_TMO])) break; if (sp > XB_SPIN_CAP) { atomicAdd(&bar[XB_TMO], 1u); break; } }
    }
    nloc = mine > 0u ? mine : 1u; nx = cnt > 0u ? cnt : 1u;
}

__device__ __forceinline__ void xcd_barrier(const XcdBarrier& b) {
    asm volatile("s_waitcnt vmcnt(0)" ::: "memory");
    __syncthreads();
    if (threadIdx.x == 0) {
        unsigned* bar = b.bar;
        __builtin_amdgcn_s_waitcnt(0);
        unsigned nloc = b.st[0], nx = b.st[1];
        if (nloc == 0u) { xcd_barrier_complete(bar, b.x, nloc, nx); b.st[0] = nloc; b.st[1] = nx; }
        const unsigned old = xb_add(&bar[XB_XSUB(b.x)], 1u);
        const unsigned gen = old / nloc;
        if (old + 1u == (gen + 1u) * nloc) {
            __builtin_amdgcn_fence(__ATOMIC_RELEASE, "agent");
            asm volatile("s_waitcnt vmcnt(0)" ::: "memory");
            const unsigned og = xb_add(&bar[XB_TOP], 1u);
            const unsigned tg = og / nx;
            if (og + 1u == (tg + 1u) * nx) xb_add(&bar[XB_TOPGEN], 1u);
            else XB_SPIN(xb_ld(&bar[XB_TOPGEN]) == tg, bar);
            __builtin_amdgcn_fence(__ATOMIC_ACQUIRE, "agent");
            xb_add(&bar[XB_XGEN(b.x)], 1u);
            asm volatile("s_waitcnt vmcnt(0)" ::: "memory");
        } else {
            XB_SPIN(xb_ld(&bar[XB_XGEN(b.x)]) == gen, bar);
            __builtin_amdgcn_fence(__ATOMIC_ACQUIRE, "agent");
            asm volatile("s_waitcnt vmcnt(0)" ::: "memory");
        }
    }
    __syncthreads();
}

#ifndef REP_M1
#define REP_M1 1
#endif
#ifndef REP_M2
#define REP_M2 1
#endif
#define MK_CTX() Ctx c; c.lds = (LAS unsigned char*)lds_raw; c.ldsg = lds_raw; \
        { unsigned long long kp = (unsigned long long)__builtin_amdgcn_kernarg_segment_ptr(); asm volatile("" : "+s"(kp)); c.a = (KArgs)kp; } \
        c.ws = c.a->ws; { int t = threadIdx.x; asm volatile("" : "+v"(t)); c.tid = t; } \
        c.lane = c.tid & 63; c.wave = __builtin_amdgcn_readfirstlane(c.tid >> 6); c.bid = blockIdx.x; c.G = gridDim.x;
#define MK_GROUP(k, body) do { if (lo <= (k) && (k) < hi) { { MK_CTX(); body; } if ((k) + 1 < hi) { if ((k) == 0) grid.sync(); else xcd_barrier(bar); } } } while (0)
__global__ void __launch_bounds__(NTHREADS, 2) fwd_kernel(Args args) {
    extern __shared__ __attribute__((aligned(16))) unsigned char lds_raw[];
    cg::grid_group grid = cg::this_grid();
    const int lo = args.ph_lo, hi = args.ph_hi;
    if (threadIdx.x < 16) ((LAS unsigned*)(lds_raw + MISC_OFF))[threadIdx.x] = 0u;
    __syncthreads();
    XcdBarrier bar; bar.bar = nullptr; bar.x = 0; bar.st = nullptr;
    if (hi - lo > 1) bar = xcd_barrier_post((unsigned*)(args.ws + WS_CTL) + CW_BAR, (volatile LAS unsigned*)((LAS unsigned char*)lds_raw + MISC_OFF));
    MK_GROUP(0, run_stage<10>(c, 0));
#pragma unroll
    for (int L = 0; L < DEPTH; ++L) {
        const int k0 = 1 + 8 * L;
        MK_GROUP(k0 + 0, run_stage<0>(c, L));
        MK_GROUP(k0 + 1, for (int rep_ = 0; rep_ < REP_M1; ++rep_) run_stage<1>(c, L));
        MK_GROUP(k0 + 2, for (int rep_ = 0; rep_ < REP_M2; ++rep_) run_stage<2>(c, L));
        MK_GROUP(k0 + 3, run_stage<3>(c, L));
        MK_GROUP(k0 + 4, run_stage<4>(c, L));
        MK_GROUP(k0 + 5, run_stage<5>(c, L); run_stage<6>(c, L));
        MK_GROUP(k0 + 6, run_stage<7>(c, L); run_stage<8>(c, L));
        MK_GROUP(k0 + 7, run_stage<9>(c, L));
    }
}
#ifndef MK_PER_PHASE
#define MK_PER_PHASE 0
#endif
extern "C" void kernel_launch(void* const* d_in, const int* in_sizes, int n_in, void* d_out, int out_size, void* d_ws, size_t ws_size, hipStream_t stream) {
    static int grid = 0;
    if (grid == 0) {
        if (n_in != 32 || out_size != M * D || ws_size < WS_END) { fprintf(stderr, "kernel_launch: unexpected shapes (n_in %d out %d ws %zu)\n", n_in, out_size, ws_size); grid = -1; return; }
        int dev = 0, cus = 0, per_cu = 0;
        (void)hipGetDevice(&dev); (void)hipDeviceGetAttribute(&cus, hipDeviceAttributeMultiprocessorCount, dev);
        (void)hipFuncSetAttribute((const void*)fwd_kernel, hipFuncAttributeMaxDynamicSharedMemorySize, LDS_BYTES);
        (void)hipOccupancyMaxActiveBlocksPerMultiprocessor(&per_cu, (const void*)fwd_kernel, NTHREADS, LDS_BYTES);
        if (per_cu < 1) { fprintf(stderr, "kernel_launch: occupancy query says %d blocks/CU\n", per_cu); }
        (void)hipGetLastError();
        grid = cus;
    }
    if (grid < 0) return;
    Args a{};
    for (int i = 0; i < 32; ++i) a.in[i] = d_in[i];
    a.out = (float*)d_out; a.ws = (unsigned char*)d_ws;
#if MK_PER_PHASE
    for (int ph = 0; ph < N_GROUPS; ++ph) { a.ph_lo = ph; a.ph_hi = ph + 1; hipLaunchKernelGGL(fwd_kernel, dim3(grid), dim3(NTHREADS), LDS_BYTES, stream, a); }
#else
    a.ph_lo = 0; a.ph_hi = N_GROUPS;
    if (hipMemsetAsync((char*)d_ws + WS_CTL, 0, CTL_ZERO_BYTES, stream) != hipSuccess) { fprintf(stderr, "kernel_launch: memset failed\n"); return; }
    void* kargs[] = {&a};
    hipError_t e = hipLaunchCooperativeKernel((const void*)fwd_kernel, dim3(grid), dim3(NTHREADS), kargs, LDS_BYTES, stream);
    if (e != hipSuccess) fprintf(stderr, "cooperative launch failed: %s (grid %d)\n", hipGetErrorString(e), grid);
#endif
}
```
